# Optimizing an MI355X kernel written in HIP

```python
import math
import jax, jax.numpy as jnp
from jax import lax
import numpy as np

D_MODEL = 1024
BATCH = 4
SEQ = 8192
DEPTH = 2

CHUNK = 64
N_META = 16
N_A_LAYERS = DEPTH // 2
N_B_LAYERS = DEPTH - N_A_LAYERS
CONV_W = 3
HEAD_DIM = 64
N_HEADS = D_MODEL // (2 * HEAD_DIM)
ROT_DIM = HEAD_DIM // 4
ROPE_THETA = 500000.0
Q_BLOCK = 128
N_GROUPS = 4
EXPERTS_PER_GROUP = 8
N_EXPERTS = N_GROUPS * EXPERTS_PER_GROUP
TOP_K = 2
D_EXPERT = 512
ROW_BLOCK = 128
EPS = 1e-6

kernel_name = "yoco_shortconv_diffattn_hiermoe"


def rmsnorm(x, g):
    xf = x.astype(jnp.float32)
    y = xf * lax.rsqrt(jnp.mean(xf * xf, axis=-1, keepdims=True) + EPS) * g.astype(jnp.float32)
    return y.astype(x.dtype)


def partial_rotary(x, pos):
    half = ROT_DIM // 2
    inv_freq = ROPE_THETA ** (-jnp.arange(half, dtype=jnp.float32) * 2.0 / ROT_DIM)
    ang = pos.astype(jnp.float32)[:, None] * inv_freq[None, :]
    ang = ang.reshape((1, ang.shape[0]) + (1,) * (x.ndim - 3) + (half,))
    cos, sin = jnp.cos(ang), jnp.sin(ang)
    xf = x.astype(jnp.float32)
    x1, x2, rest = xf[..., :half], xf[..., half:ROT_DIM], xf[..., ROT_DIM:]
    out = jnp.concatenate([x1 * cos - x2 * sin, x2 * cos + x1 * sin, rest], axis=-1)
    return out.astype(x.dtype)


def short_conv_mixer(hn, w_in, conv_w, w_out):
    d = hn.shape[-1]
    b_gate, c_gate, u = jnp.split(hn @ w_in, 3, axis=-1)
    z = lax.conv_general_dilated(
        c_gate * u, conv_w[:, None, :].astype(hn.dtype), window_strides=(1,),
        padding=[(CONV_W - 1, 0)], dimension_numbers=("NWC", "WIO", "NWC"),
        feature_group_count=d)
    return (b_gate * z) @ w_out


def grouped_experts(xf, expert, gate, w_gate, w_up, w_down):
    t, d = xf.shape
    a = t * TOP_K
    n_blk = a // ROW_BLOCK + N_EXPERTS
    rows = n_blk * ROW_BLOCK
    e_flat = expert.reshape(-1)
    order = jnp.argsort(e_flat)
    e_sorted = e_flat[order]
    counts = jnp.bincount(e_flat, length=N_EXPERTS)
    padded = (counts + ROW_BLOCK - 1) // ROW_BLOCK * ROW_BLOCK
    ends = jnp.cumsum(padded)
    pad_start = ends - padded
    start = jnp.cumsum(counts) - counts
    dest = pad_start[e_sorted] + (jnp.arange(a) - start[e_sorted])
    src_tok = order // TOP_K
    buf = jnp.zeros((rows, d), xf.dtype).at[dest].set(xf[src_tok])
    row_w = jnp.zeros((rows,), jnp.float32).at[dest].set(gate.reshape(-1)[order])
    row_tok = jnp.zeros((rows,), jnp.int32).at[dest].set(src_tok.astype(jnp.int32))
    blk_expert = jnp.minimum(
        jnp.searchsorted(ends, jnp.arange(n_blk) * ROW_BLOCK, side="right"), N_EXPERTS - 1)

    def run_block(args):
        xb, e = args
        return (jax.nn.silu(xb @ w_gate[e]) * (xb @ w_up[e])) @ w_down[e]

    yb = lax.map(run_block, (buf.reshape(n_blk, ROW_BLOCK, d), blk_expert))
    y = yb.reshape(rows, d) * row_w[:, None].astype(xf.dtype)
    return jax.ops.segment_sum(y, row_tok, num_segments=t)


def hier_moe(hn, w_rg, b_rg, w_re, b_re, w_gate, w_up, w_down):
    shp = hn.shape
    xf = hn.reshape(-1, shp[-1])
    t = xf.shape[0]
    lg = (xf @ w_rg).astype(jnp.float32) + b_rg.astype(jnp.float32)
    grp = jnp.argmax(lg, axis=-1)
    p_grp = jnp.take_along_axis(jax.nn.softmax(lg, axis=-1), grp[:, None], axis=-1)
    le = ((xf @ w_re).astype(jnp.float32) + b_re.astype(jnp.float32)).reshape(
        t, N_GROUPS, EXPERTS_PER_GROUP)
    le = jnp.take_along_axis(le, grp[:, None, None], axis=1)[:, 0]
    top_v, top_i = lax.top_k(le, TOP_K)
    gate = p_grp * jax.nn.softmax(top_v, axis=-1)
    expert = grp[:, None].astype(jnp.int32) * EXPERTS_PER_GROUP + top_i.astype(jnp.int32)
    return grouped_experts(xf, expert, gate, w_gate, w_up, w_down).reshape(shp)


def lambda_init(layer_idx):
    return 0.8 - 0.6 * math.exp(-0.3 * layer_idx)


def diff_attention(hn, w_q, lam_p, subln_g, w_out, kk, v, key_chunk, lam_init):
    bsz, seq, _ = hn.shape
    n_blk = seq // Q_BLOCK
    q = (hn @ w_q).reshape(bsz, seq, N_HEADS, 2, HEAD_DIM)
    q = partial_rotary(q, N_META + jnp.arange(seq)) * (HEAD_DIM ** -0.5)
    q = q.reshape(bsz, n_blk, Q_BLOCK, N_HEADS, 2, HEAD_DIM).transpose(1, 4, 0, 3, 2, 5)
    q_chunk = (1 + jnp.arange(seq) // CHUNK).reshape(n_blk, Q_BLOCK)
    lp = lam_p.astype(jnp.float32)
    lam = jnp.exp(jnp.sum(lp[0] * lp[1])) - jnp.exp(jnp.sum(lp[2] * lp[3])) + lam_init

    def attend(args):
        qb, qc = args
        visible = key_chunk[None, :] <= qc[:, None]
        s = jnp.einsum("nbhqd,nbhkd->nbhqk", qb, kk, preferred_element_type=jnp.float32)
        p = jax.nn.softmax(jnp.where(visible, s, jnp.finfo(jnp.float32).min), axis=-1)
        a = p[0] - lam * p[1]
        return jnp.einsum("bhqk,bhkd->bhqd", a.astype(v.dtype), v)

    o = lax.map(attend, (q, q_chunk))
    o = o.transpose(1, 0, 3, 2, 4).reshape(bsz, seq, N_HEADS, 2 * HEAD_DIM)
    o = rmsnorm(o, subln_g) * (1.0 - lam_init)
    return o.reshape(bsz, seq, N_HEADS * 2 * HEAD_DIM) @ w_out


def setup_inputs(seed: int = 0) -> dict:
    key = jax.random.key(seed)
    ks = jax.random.split(key, 24)
    d, f, e = D_MODEL, D_EXPERT, N_EXPERTS
    nrm = lambda k, shp, s: jax.random.normal(k, shp, jnp.float32) * s
    gain = lambda k, shp: 1.0 + 0.02 * jax.random.normal(k, shp, jnp.float32)
    return {
        "x": jax.random.normal(ks[0], (BATCH, SEQ, d), jnp.float32),
        "meta_tokens": nrm(ks[1], (N_META, d), 1.0),
        "a_norm": gain(ks[2], (N_A_LAYERS, d)),
        "a_w_in": nrm(ks[3], (N_A_LAYERS, d, 3 * d), d ** -0.5),
        "a_conv": nrm(ks[4], (N_A_LAYERS, CONV_W, d), CONV_W ** -0.5),
        "a_w_out": nrm(ks[5], (N_A_LAYERS, d, d), d ** -0.5),
        "kv_norm": gain(ks[6], (d,)),
        "w_kv": nrm(ks[7], (d, 2 * d), d ** -0.5),
        "b_norm": gain(ks[8], (N_B_LAYERS, d)),
        "b_w_q": nrm(ks[9], (N_B_LAYERS, d, d), d ** -0.5),
        "b_lambda": nrm(ks[10], (N_B_LAYERS, 4, HEAD_DIM), 0.1),
        "b_subln": gain(ks[11], (N_B_LAYERS, 2 * HEAD_DIM)),
        "b_w_out": nrm(ks[12], (N_B_LAYERS, d, d), d ** -0.5),
        "ffn_norm": gain(ks[13], (DEPTH, d)),
        "r_group": nrm(ks[14], (DEPTH, d, N_GROUPS), d ** -0.5),
        "r_group_b": nrm(ks[15], (DEPTH, N_GROUPS), 0.01),
        "r_expert": nrm(ks[16], (DEPTH, d, e), d ** -0.5),
        "r_expert_b": nrm(ks[17], (DEPTH, e), 0.01),
        "e_gate": nrm(ks[18], (DEPTH, e, d, f), d ** -0.5),
        "e_up": nrm(ks[19], (DEPTH, e, d, f), d ** -0.5),
        "e_down": nrm(ks[20], (DEPTH, e, f, d), f ** -0.5),
        "final_norm": gain(ks[21], (d,)),
    }


def reference(x, meta_tokens, a_norm, a_w_in, a_conv, a_w_out, kv_norm, w_kv, b_norm, b_w_q,
              b_lambda, b_subln, b_w_out, ffn_norm, r_group, r_group_b, r_expert, r_expert_b,
              e_gate, e_up, e_down, final_norm):
    bsz, seq, d = x.shape
    length = seq + N_META
    meta = jnp.broadcast_to(meta_tokens.astype(x.dtype)[None], (bsz, N_META, d))
    h = jnp.concatenate([meta, x], axis=1)
    layer = 0
    for i in range(N_A_LAYERS):
        h = h + short_conv_mixer(rmsnorm(h, a_norm[i]), a_w_in[i], a_conv[i], a_w_out[i])
        h = h + hier_moe(rmsnorm(h, ffn_norm[layer]), r_group[layer], r_group_b[layer],
                         r_expert[layer], r_expert_b[layer], e_gate[layer], e_up[layer],
                         e_down[layer])
        layer += 1
    kv = rmsnorm(h, kv_norm) @ w_kv
    k = kv[..., :d].reshape(bsz, length, N_HEADS, 2, HEAD_DIM)
    k = partial_rotary(k, jnp.arange(length)).transpose(3, 0, 2, 1, 4)
    v = kv[..., d:].reshape(bsz, length, N_HEADS, 2 * HEAD_DIM).transpose(0, 2, 1, 3)
    pos = jnp.arange(length)
    key_chunk = jnp.where(pos < N_META, 0, 1 + (pos - N_META) // CHUNK)
    h = h[:, N_META:]
    for j in range(N_B_LAYERS):
        h = h + diff_attention(rmsnorm(h, b_norm[j]), b_w_q[j], b_lambda[j], b_subln[j],
                               b_w_out[j], k, v, key_chunk, lambda_init(layer))
        h = h + hier_moe(rmsnorm(h, ffn_norm[layer]), r_group[layer], r_group_b[layer],
                         r_expert[layer], r_expert_b[layer], e_gate[layer], e_up[layer],
                         e_down[layer])
        layer += 1
    return rmsnorm(h, final_norm)
```

```cpp
#include <hip/hip_runtime.h>
#include <cstdint>
#include <cstdio>

#define DI __device__ __forceinline__
#define LAS __attribute__((address_space(3)))
#define GAS __attribute__((address_space(1)))

typedef unsigned short bf16;
typedef short bf16x8 __attribute__((ext_vector_type(8)));
typedef short s16x4 __attribute__((ext_vector_type(4)));
typedef float f32x4 __attribute__((ext_vector_type(4)));
typedef float f32x2 __attribute__((ext_vector_type(2)));
typedef float f32x16 __attribute__((ext_vector_type(16)));
typedef unsigned u32x4 __attribute__((ext_vector_type(4)));
typedef unsigned u32x2 __attribute__((ext_vector_type(2)));
typedef __bf16 bf16x2_t __attribute__((ext_vector_type(2)));

constexpr int D = 1024, NB = 4, SEQ = 8192, NMETA = 16;
constexpr int TR = NB * SEQ;
constexpr int NV = TR + NMETA;
constexpr int MP = 129 * 256;
constexpr int NH = 8, HD = 64, NE = 32, NGRP = 4, EPG = 8, DE = 512;
constexpr int CAP = NV;
constexpr float EPS = 1e-6f;
constexpr float LAM_INIT = 0.35550906f;
constexpr float QSCALE = 0.125f * 1.4426950408889634f;

constexpr size_t MiB = 1u << 20;
constexpr size_t WS_CTL = 0, CTL_ZERO_BYTES = 1 * MiB;
constexpr size_t WS_RW = 1 * MiB;
constexpr size_t WS_RSTD = 1 * MiB + 384 * 1024;
constexpr size_t WS_ROPE = 1 * MiB + 640 * 1024;
constexpr size_t WS_LIST = 3 * MiB;
constexpr size_t WS_WIN = 8 * MiB, WS_WOUT = 14 * MiB, WS_WQKV = 16 * MiB, WS_WO = 22 * MiB;
constexpr size_t WS_EGU = 24 * MiB;
constexpr size_t WS_ED = 88 * MiB;
constexpr size_t WS_XN = 120 * MiB;
constexpr size_t WS_R2 = 185 * MiB;
constexpr size_t WS_R3 = 250 * MiB;
constexpr size_t WS_Y = 315 * MiB;
constexpr size_t WS_K = WS_Y, WS_V = WS_Y + 65 * MiB;
constexpr size_t WS_RSTDP = 446 * MiB, WS_GATEP = 452 * MiB;
constexpr size_t WS_K8 = WS_K, WS_V8 = WS_V;
constexpr size_t WS_END = 458 * MiB;
static_assert(WS_RW + 2 * 48 * 1024 * 2 <= WS_RSTD && WS_RSTD + MP * 4 <= WS_ROPE && WS_ROPE + 8211 * 16 * 4 <= WS_LIST && WS_LIST + 32ull * CAP * 4 <= WS_WIN, "ws map small");
static_assert(WS_XN + (size_t)MP * D * 2 <= WS_R2 && WS_R2 + (size_t)MP * D * 2 <= WS_R3 && WS_R3 + (size_t)MP * D * 2 <= WS_Y && WS_Y + 2ull * MP * D * 2 <= WS_RSTDP && WS_GATEP + 6 * MiB <= WS_END, "ws map");
constexpr int CW_CNT = 64;
constexpr int CW_BAR = 4096;
constexpr int CW_SIG = 8192;

constexpr int RING_BYTES = 131072;
constexpr int MISC_OFF = 135168;
constexpr int LDS_BYTES = 147456;
constexpr int NWAVES = 8;

DI unsigned cvtpk(float lo, float hi) { f32x2 v = {lo, hi}; bf16x2_t b = __builtin_convertvector(v, bf16x2_t); return __builtin_bit_cast(unsigned, b); }
DI float bf2f(unsigned short h) { return __uint_as_float(((unsigned)h) << 16); }
DI float bflo(unsigned w) { return __uint_as_float(w << 16); }
DI float bfhi(unsigned w) { return __uint_as_float(w & 0xffff0000u); }
DI u32x4 pack8(const f32x4& a, const f32x4& b) { u32x4 w; w.x = cvtpk(a[0], a[1]); w.y = cvtpk(a[2], a[3]); w.z = cvtpk(b[0], b[1]); w.w = cvtpk(b[2], b[3]); return w; }
DI float wave_sum(float v) {
#pragma unroll
    for (int o = 1; o < 64; o <<= 1) v += __shfl_xor(v, o);
    return v;
}
#define LDS_WAIT() asm volatile("s_waitcnt lgkmcnt(0)" ::: "memory")
#define VM_WAIT() asm volatile("s_waitcnt vmcnt(0)" ::: "memory")

#define XB_TMO      128
#define XB_XCNT(j)  (256  + 64 * (j))
#define XB_XSUB(j)  (1280 + 64 * (j))
#define XB_XGEN(j)  (2304 + 64 * (j))
#define XB_TOP      3328
#define XB_TOPGEN   3392
#define XCD_BAR_WORDS 3456
#define XB_SPIN_CAP (1u << 18)
DI unsigned xb_ld(unsigned* p)              { return __hip_atomic_load(p, __ATOMIC_RELAXED, __HIP_MEMORY_SCOPE_AGENT); }
DI unsigned xb_add(unsigned* p, unsigned v) { return __hip_atomic_fetch_add(p, v, __ATOMIC_RELAXED, __HIP_MEMORY_SCOPE_AGENT); }
DI unsigned xb_xcc_id() { return (unsigned)__builtin_amdgcn_s_getreg((3 << 11) | 20) & 0xFu; }
#define XB_SPIN(cond, bar) do { unsigned _sp = 0; while (cond) { __builtin_amdgcn_s_sleep(1); \
    if ((++_sp & 255u) == 0u) { if (xb_ld(&(bar)[XB_TMO])) break; if (_sp > XB_SPIN_CAP) { atomicAdd(&(bar)[XB_TMO], 1u); break; } } } } while (0)
struct XcdBarrier { unsigned* bar; unsigned x; volatile LAS unsigned* st; };
DI XcdBarrier xcd_barrier_post(unsigned* bar, volatile LAS unsigned* st) {
    XcdBarrier b; b.bar = bar; b.x = xb_xcc_id(); b.st = st;
    if (threadIdx.x == 0) (void)xb_add(&bar[XB_XCNT(b.x)], 1u);
    return b;
}
DI void xcd_barrier_complete(unsigned* bar, unsigned x, unsigned& nloc, unsigned& nx) {
    const unsigned G = gridDim.x * gridDim.y * gridDim.z;
    unsigned sum, cnt, mine, sp = 0u;
    for (;;) {
        sum = 0u; cnt = 0u; mine = 0u;
#pragma unroll
        for (unsigned j = 0; j < 16; ++j) { const unsigned c = xb_ld(&bar[XB_XCNT(j)]); sum += c; cnt += (c > 0u) ? 1u : 0u; mine = (j == x) ? c : mine; }
        if (sum == G) break;
        __builtin_amdgcn_s_sleep(1);
        if ((++sp & 255u) == 0u) { if (xb_ld(&bar[XB_TMO])) break; if (sp > XB_SPIN_CAP) { atomicAdd(&bar[XB_TMO], 1u); break; } }
    }
    nloc = mine > 0u ? mine : 1u; nx = cnt > 0u ? cnt : 1u;
}
DI void xcd_barrier(const XcdBarrier& b) {
    asm volatile("s_waitcnt vmcnt(0)" ::: "memory");
    __syncthreads();
    if (threadIdx.x == 0) {
        unsigned* bar = b.bar;
        __builtin_amdgcn_s_waitcnt(0);
        unsigned nloc = b.st[0], nx = b.st[1];
        if (nloc == 0u) { xcd_barrier_complete(bar, b.x, nloc, nx); b.st[0] = nloc; b.st[1] = nx; }
        const unsigned old = xb_add(&bar[XB_XSUB(b.x)], 1u);
        const unsigned gen = old / nloc;
        if (old + 1u == (gen + 1u) * nloc) {
            __builtin_amdgcn_fence(__ATOMIC_RELEASE, "agent");
            asm volatile("s_waitcnt vmcnt(0)" ::: "memory");
            const unsigned og = xb_add(&bar[XB_TOP], 1u);
            const unsigned tg = og / nx;
            if (og + 1u == (tg + 1u) * nx) xb_add(&bar[XB_TOPGEN], 1u);
            else XB_SPIN(xb_ld(&bar[XB_TOPGEN]) == tg, bar);
            __builtin_amdgcn_fence(__ATOMIC_ACQUIRE, "agent");
            xb_add(&bar[XB_XGEN(b.x)], 1u);
            asm volatile("s_waitcnt vmcnt(0)" ::: "memory");
        } else {
            XB_SPIN(xb_ld(&bar[XB_XGEN(b.x)]) == gen, bar);
            __builtin_amdgcn_fence(__ATOMIC_ACQUIRE, "agent");
            asm volatile("s_waitcnt vmcnt(0)" ::: "memory");
        }
    }
    __syncthreads();
}

namespace pg8 {
constexpr int BM = 256, BK = 64, HALF = 128, HTB = HALF * BK * 2, STAGE_BYTES = 8 * HTB, NXCD = 8, WGM = 8;
DI int lds_byte(int r, int c) { const int st = (r >> 4) * 2 + (c >> 5), rr = r & 15, cc = c & 31, ob = rr * 64 + cc * 2; return st * 1024 + (ob ^ (((ob >> 9) & 1) << 5)); }
DI void stage_rc(int b, int& R, int& C) { const int st = b / 1024, sb = b % 1024, swz = sb ^ (((sb >> 9) & 1) << 5); R = (st >> 1) * 16 + swz / 64; C = (st & 1) * 32 + (swz % 64) / 2; }
DI int perm32(int rho) { const int n = rho >> 4, i = rho & 15; return 8 * (i >> 2) + 4 * n + (i & 3); }
struct Unit { int pm, pn, e, rb; };

template <class Epi, class Sched, bool ALIGN_EPI>
DI void gemm_phase(LAS unsigned char* lds, const int K, const Sched S, const Epi E) {
    const int tid = threadIdx.x, wid = __builtin_amdgcn_readfirstlane(tid >> 6), lane = tid & 63, wr = wid >> 2, wc = wid & 3, fr = lane & 15, fq = lane >> 4;
    const int nt = K / BK;
    int RA[2], CA[2]; unsigned voffB[2];
#pragma unroll
    for (int i = 0; i < 2; ++i) { int R, C; stage_rc(tid * 16 + i * 8192, R, C); const int Rb = (R & ~31) + perm32(R & 31);
        RA[i] = R; CA[i] = C; voffB[i] = (unsigned)(Rb * K + C) * 2u; }
    const size_t kstep = (size_t)(BK * 2);
    const size_t hstepB = (size_t)HALF * K * 2;
    const unsigned ldsw = (unsigned)wid * 1024u;
    const int aoff = lds_byte(wr * 64 + fr, fq * 8), boff = lds_byte(wc * 32 + fr, fq * 8);
    const char* const Abase = (const char*)S.A;
#define PG8_SA(b, h) (((b) * 2 + (h)) * HTB)
#define PG8_SB(b, h) ((4 + (b) * 2 + (h)) * HTB)
#define PG8_STAGE_B(bufoff, gbase) do { _Pragma("unroll") for (int _i = 0; _i < 2; ++_i) \
        __builtin_amdgcn_global_load_lds((const unsigned*)((const char*)(gbase) + voffB[_i]), (LAS unsigned*)(lds + (bufoff) + ldsw + _i * 8192), 16, 0, 0); } while (0)
#define PG8_STAGE_A(bufoff, kb, offs) do { _Pragma("unroll") for (int _i = 0; _i < 2; ++_i) \
        __builtin_amdgcn_global_load_lds((const unsigned*)(Abase + (size_t)(offs)[_i] + (size_t)(kb)), (LAS unsigned*)(lds + (bufoff) + ldsw + _i * 8192), 16, 0, 0); } while (0)
#define PG8_LDA(dst, b, h) do { _Pragma("unroll") for (int m = 0; m < 4; ++m) _Pragma("unroll") for (int k = 0; k < 2; ++k) dst[m][k] = *(const LAS bf16x8*)(lds + PG8_SA(b, h) + aoff + m * 2048 + k * 1024); } while (0)
#define PG8_LDB(dst, b, h) do { _Pragma("unroll") for (int n = 0; n < 2; ++n) _Pragma("unroll") for (int k = 0; k < 2; ++k) dst[n][k] = *(const LAS bf16x8*)(lds + PG8_SB(b, h) + boff + n * 2048 + k * 1024); } while (0)
#define PG8_MMA(ai, bj, At, Bt) do { __builtin_amdgcn_s_setprio(1); _Pragma("unroll") for (int m = 0; m < 4; ++m) _Pragma("unroll") for (int n = 0; n < 2; ++n) _Pragma("unroll") for (int k = 0; k < 2; ++k) \
        acc[ai][bj][m][n] = __builtin_amdgcn_mfma_f32_16x16x32_bf16(Bt[n][k], At[m][k], acc[ai][bj][m][n], 0, 0, 0); __builtin_amdgcn_s_setprio(0); } while (0)
#define PG8_WAIT_V(n) asm volatile("s_waitcnt vmcnt(" #n ")" ::: "memory")
#define PG8_WAIT_L(n) asm volatile("s_waitcnt lgkmcnt(" #n ")" ::: "memory")
#define PG8_BAR __builtin_amdgcn_s_barrier()
#define PG8_SCHED __builtin_amdgcn_sched_barrier(0)
    Unit cur, nxt; int ui = 0;
    if (!S.next(0, cur)) return;
    f32x4 acc[2][2][4][2];
#pragma unroll
    for (int a = 0; a < 2; ++a)
#pragma unroll
        for (int b = 0; b < 2; ++b)
#pragma unroll
            for (int m = 0; m < 4; ++m)
#pragma unroll
                for (int n = 0; n < 2; ++n) acc[a][b][m][n] = (f32x4){0.f, 0.f, 0.f, 0.f};
    bf16x8 At[4][2], B0[2][2], B1[2][2];
    unsigned ao_c[2][2], ao_n[2][2];
    S.a_rows(cur, RA, CA, ao_c);
#pragma unroll
    for (int h = 0; h < 2; ++h)
#pragma unroll
        for (int i = 0; i < 2; ++i) asm volatile("" : "+v"(ao_c[h][i]));
    const char* cB = S.b_base(cur);
    E.pre(cur, wr, fr);
    PG8_STAGE_B(PG8_SB(0, 0), cB); PG8_STAGE_B(PG8_SB(0, 1), cB + hstepB); PG8_STAGE_A(PG8_SA(0, 0), 0, ao_c[0]); PG8_STAGE_A(PG8_SA(0, 1), 0, ao_c[1]);
    if (wr == 1) PG8_BAR;
    PG8_WAIT_V(2); PG8_BAR;
    PG8_STAGE_B(PG8_SB(1, 0), cB + kstep); PG8_STAGE_A(PG8_SA(1, 0), kstep, ao_c[0]); PG8_STAGE_B(PG8_SB(1, 1), cB + hstepB + kstep);
    PG8_WAIT_V(6); PG8_BAR;
    for (;;) {
        const bool has_next = S.next(ui + 1, nxt);
        const char* nB = cB;
        if (has_next) { S.a_rows(nxt, RA, CA, ao_n); nB = S.b_base(nxt); }
        else {
#pragma unroll
            for (int h = 0; h < 2; ++h)
#pragma unroll
                for (int i = 0; i < 2; ++i) ao_n[h][i] = ao_c[h][i];
        }
#pragma unroll
        for (int h = 0; h < 2; ++h)
#pragma unroll
            for (int i = 0; i < 2; ++i) asm volatile("" : "+v"(ao_n[h][i]));
        for (int t = 0; t < nt; t += 2) {
            const bool last = (t == nt - 2);
            const size_t k1 = (size_t)(t + 1) * kstep;
            const size_t k2 = last ? 0 : (size_t)(t + 2) * kstep, k3 = k2 + kstep;
            unsigned a2o[2][2];
#pragma unroll
            for (int h = 0; h < 2; ++h)
#pragma unroll
                for (int i = 0; i < 2; ++i) a2o[h][i] = last ? ao_n[h][i] : ao_c[h][i];
            const char* b2 = last ? nB : cB + (size_t)(t + 2) * kstep; const char* b3 = b2 + kstep;
            PG8_LDB(B0, 0, 0); PG8_LDB(B1, 0, 1); PG8_SCHED; PG8_LDA(At, 0, 0); PG8_STAGE_A(PG8_SA(1, 1), k1, ao_c[1]);
            PG8_WAIT_V(8); PG8_WAIT_L(0); PG8_BAR; PG8_MMA(0, 0, At, B0); PG8_MMA(0, 1, At, B1); PG8_BAR; PG8_SCHED;
            PG8_LDA(At, 0, 1); PG8_STAGE_B(PG8_SB(0, 0), b2); PG8_STAGE_B(PG8_SB(0, 1), b2 + hstepB); PG8_STAGE_A(PG8_SA(0, 0), k2, a2o[0]);
            PG8_WAIT_V(8); PG8_WAIT_L(0); PG8_BAR; PG8_MMA(1, 0, At, B0); PG8_MMA(1, 1, At, B1); PG8_BAR; PG8_SCHED;
            PG8_LDB(B0, 1, 0); PG8_LDB(B1, 1, 1); PG8_SCHED; PG8_LDA(At, 1, 0); PG8_STAGE_A(PG8_SA(0, 1), k2, a2o[1]);
            PG8_WAIT_V(8); PG8_WAIT_L(0); PG8_BAR; PG8_MMA(0, 0, At, B0); PG8_MMA(0, 1, At, B1); PG8_BAR; PG8_SCHED;
            PG8_LDA(At, 1, 1); PG8_STAGE_B(PG8_SB(1, 0), b3); PG8_STAGE_B(PG8_SB(1, 1), b3 + hstepB); PG8_STAGE_A(PG8_SA(1, 0), k3, a2o[0]);
            PG8_WAIT_V(8); PG8_WAIT_L(0); PG8_BAR; PG8_MMA(1, 0, At, B0); PG8_MMA(1, 1, At, B1); PG8_BAR; PG8_SCHED;
        }
        if constexpr (ALIGN_EPI) { if (wr == 0) PG8_BAR; }
        E(acc, cur, wr, wc, fr, fq);
        S.after_unit(ui);
        if (!has_next) break;
#pragma unroll
        for (int a = 0; a < 2; ++a)
#pragma unroll
            for (int b = 0; b < 2; ++b)
#pragma unroll
                for (int m = 0; m < 4; ++m)
#pragma unroll
                    for (int n = 0; n < 2; ++n) acc[a][b][m][n] = (f32x4){0.f, 0.f, 0.f, 0.f};
        cur = nxt; cB = nB; ++ui;
        E.pre(cur, wr, fr);
#pragma unroll
        for (int h = 0; h < 2; ++h)
#pragma unroll
            for (int i = 0; i < 2; ++i) ao_c[h][i] = ao_n[h][i];
        if constexpr (ALIGN_EPI) { if (wr == 1) PG8_BAR; }
    }
    PG8_WAIT_V(0);
    if constexpr (!ALIGN_EPI) { if (wr == 0) PG8_BAR; }
    PG8_BAR;
#undef PG8_SA
#undef PG8_SB
#undef PG8_STAGE_A
#undef PG8_STAGE_B
#undef PG8_LDA
#undef PG8_LDB
#undef PG8_MMA
#undef PG8_WAIT_V
#undef PG8_WAIT_L
#undef PG8_BAR
#undef PG8_SCHED
}
}
using pg8::Unit;

struct ExpJob { const float *eg, *eu, *ed, *gain; bf16 *EGUp, *EDp; int gw, ngw; };
DI void expjob_item(const ExpJob& J, int k, int lane);
struct DenseSched {
    const void* A; const bf16* Bt; int K, nN, G, c, metaN0, metaNN; ExpJob job;
    DI void after_unit(int ui) const { if (job.eg) expjob_item(job, ui, threadIdx.x & 63); }
    DI bool next(int i, Unit& u) const {
        const int nM = 128, nwg = nM * nN; const int L = i * G + c;
        if (L >= nwg + metaNN) return false;
        u.e = 0; u.rb = 0;
        if (L >= nwg) { u.pm = 128; u.pn = metaN0 + (L - nwg); return true; }
        int wgid = L; { const int q = nwg / 8, r = nwg % 8, xcd = wgid % 8, off = wgid / 8; wgid = (xcd < r ? xcd * (q + 1) : r * (q + 1) + (xcd - r) * q) + off; }
        const int nig = 8 * nN, gid = wgid / nig, fm = gid * 8, gsz = (nM - fm) < 8 ? (nM - fm) : 8;
        u.pm = fm + ((wgid % nig) % gsz); u.pn = (wgid % nig) / gsz; return true;
    }
    DI void a_rows(const Unit& u, const int (&RA)[2], const int (&CA)[2], unsigned (&ao)[2][2]) const {
#pragma unroll
        for (int h = 0; h < 2; ++h)
#pragma unroll
            for (int i = 0; i < 2; ++i) ao[h][i] = (unsigned)((u.pm * 256 + h * 128 + RA[i]) * K + CA[i]) * 2u;
    }
    DI const char* b_base(const Unit& u) const { return (const char*)Bt + (size_t)u.pn * 256 * K * 2; }
};
template <bool GATHER>
struct MoeSched {
    const void* A; const bf16* Bt; int K, G, c; const volatile LAS int* pre; const volatile LAS int* cnt; const unsigned* list; unsigned* sig; const volatile LAS unsigned* xst; unsigned xid;
    DI bool decode(int L, Unit& u) const {
        const int blk = L >> 2; int e = 0;
        for (int j = 1; j < 32; ++j) e += (pre[j] <= blk) ? 1 : 0;
        u.e = e; u.rb = blk - pre[e]; u.pm = blk; u.pn = e * 4 + (L & 3); return true;
    }
    DI bool next(int i, Unit& u) const {
        const int U = pre[32] * 4; int L = i * G + c;
        if (!GATHER) {
            const int Rf = U / G, rem = U - Rf * G, Ne = Rf * G, F = (U + 2 * rem + G - 1) / G, nl = F - 2;
            if (nl >= 1) {
                if (c < rem) { if (i >= nl) return false; L = (i == 0) ? Ne + c : Ne - 1 - ((i - 1) * rem + c); }
                else { L = i * (G - rem) + (c - rem); if (i >= F || L >= Ne - rem * (nl - 1)) return false; }
                return decode(L, u);
            }
        }
        if (L >= U) return false;
        return decode(L, u);
    }
    DI void a_rows(const Unit& u, const int (&RA)[2], const int (&CA)[2], unsigned (&ao)[2][2]) const {
        if (GATHER) {
            const int n = cnt[u.e];
#pragma unroll
            for (int h = 0; h < 2; ++h)
#pragma unroll
                for (int i = 0; i < 2; ++i) { int pos = u.rb * 256 + h * 128 + RA[i]; pos = pos < n ? pos : 0;
                    const unsigned tokk = list[(size_t)u.e * CAP + pos]; ao[h][i] = (unsigned)((int)(tokk >> 1) * K + CA[i]) * 2u; }
        } else {
#pragma unroll
            for (int h = 0; h < 2; ++h)
#pragma unroll
                for (int i = 0; i < 2; ++i) ao[h][i] = (unsigned)((u.pm * 256 + h * 128 + RA[i]) * K + CA[i]) * 2u;
        }
    }
    DI void after_unit(int ui) const {
        if (GATHER && sig) { const int Rf = (pre[32] * 4) / G;
            if (ui == Rf - 1 || ui == Rf) {
                asm volatile("s_waitcnt vmcnt(0)" ::: "memory"); __syncthreads();
                if (threadIdx.x == 0) {
                    if (ui == Rf) { __builtin_amdgcn_fence(__ATOMIC_RELEASE, "agent"); asm volatile("s_waitcnt vmcnt(0)" ::: "memory"); xb_add(sig + 32, 1u); }
                    else { const unsigned nloc = xst[0]; const unsigned old = xb_add(sig + 1024 + 64 * xid, 1u);
                        if (old + 1u == nloc) { __builtin_amdgcn_fence(__ATOMIC_RELEASE, "agent"); asm volatile("s_waitcnt vmcnt(0)" ::: "memory"); xb_add(sig, nloc); } }
                }
            } }
    }
    DI const char* b_base(const Unit& u) const { return (const char*)Bt + (size_t)u.pn * 256 * K * 2; }
};
DI void moe_handoff(unsigned* sig, const volatile LAS int* pre, int G, int c, unsigned* bar) {
    const int U = pre[32] * 4, Rf = U / G, rem = U - Rf * G, F = (U + 2 * rem + G - 1) / G;
    if (threadIdx.x == 0) {
        XB_SPIN(xb_ld(sig) < (unsigned)G, bar);
        if (c < rem || F < 3) XB_SPIN(xb_ld(sig + 32) < (unsigned)rem, bar);
        __builtin_amdgcn_fence(__ATOMIC_ACQUIRE, "agent"); asm volatile("s_waitcnt vmcnt(0)" ::: "memory");
    }
    __syncthreads();
}

DI float xrow16(float v, int fq) { auto rr = __builtin_amdgcn_permlane16_swap(__float_as_uint(v), __float_as_uint(v), false, false); return __uint_as_float((fq & 1) ? rr[0] : rr[1]); }
typedef f32x4 Acc[2][2][4][2];
DI void st16(bf16* p, u32x4 v) { *(u32x4*)p = v; }
struct EpiInProj {
    bf16* Bo; bf16* CUo; const float* rstd; mutable float rsv[8];
    DI void pre(const Unit& u, int wr, int fr) const {
#pragma unroll
        for (int q = 0; q < 8; ++q) rsv[q] = rstd[u.pm * 256 + wr * 64 + fr + (q >> 2) * 128 + (q & 3) * 16]; }
    DI void operator()(const Acc& acc, const Unit& u, int wr, int wc, int fr, int fq) const {
        const int row0 = u.pm * 256 + wr * 64 + fr;
        if (u.pn < 4) {
            const int col0 = u.pn * 256 + wc * 32 + 8 * fq;
#pragma unroll
            for (int ai = 0; ai < 2; ++ai)
#pragma unroll
                for (int m = 0; m < 4; ++m) { const int r = row0 + ai * 128 + m * 16; const float rs = rsv[ai * 4 + m]; bf16* rowp = Bo + (size_t)r * D + col0;
#pragma unroll
                    for (int bj = 0; bj < 2; ++bj) st16(rowp + bj * 128, pack8(acc[ai][bj][m][0] * rs, acc[ai][bj][m][1] * rs)); }
        } else {
            const int col0 = (u.pn - 4) * 128 + wc * 32 + 8 * fq;
#pragma unroll
            for (int ai = 0; ai < 2; ++ai)
#pragma unroll
                for (int m = 0; m < 4; ++m) { const int r = row0 + ai * 128 + m * 16; const float rs = rsv[ai * 4 + m]; const float rs2 = rs * rs; bf16* rowp = CUo + (size_t)r * D + col0;
                    st16(rowp, pack8(acc[ai][0][m][0] * acc[ai][1][m][0] * rs2, acc[ai][0][m][1] * acc[ai][1][m][1] * rs2)); }
        }
    }
};
template <bool F32RES>
struct EpiResid {
    const float* res_main; const float* res_meta; bf16* hb;
    DI void pre(const Unit&, int, int) const {}
    DI void operator()(const Acc& acc, const Unit& u, int wr, int wc, int fr, int fq) const {
        const int row0 = u.pm * 256 + wr * 64 + fr;
#pragma unroll
        for (int ai = 0; ai < 2; ++ai)
#pragma unroll
            for (int m = 0; m < 4; ++m) {
                const int r = row0 + ai * 128 + m * 16;
                if (r >= (F32RES ? NV : TR)) continue;
                bf16* op = hb + (size_t)r * D;
#pragma unroll
                for (int bj = 0; bj < 2; ++bj) {
                    const int col = u.pn * 256 + bj * 128 + wc * 32 + 8 * fq;
                    f32x4 x0, x1;
                    if (F32RES) { const float* rp = (r < TR) ? res_main + (size_t)r * D : res_meta + (size_t)(r - TR) * D; x0 = *(const f32x4*)(rp + col); x1 = *(const f32x4*)(rp + col + 4); }
                    else { const u32x4 w = *(const u32x4*)(op + col); x0 = (f32x4){bflo(w.x), bfhi(w.x), bflo(w.y), bfhi(w.y)}; x1 = (f32x4){bflo(w.z), bfhi(w.z), bflo(w.w), bfhi(w.w)}; }
                    st16(op + col, pack8(x0 + acc[ai][bj][m][0], x1 + acc[ai][bj][m][1]));
                }
            }
    }
};
DI float silu_mul(float g, float u) { return g * __builtin_amdgcn_rcpf(1.0f + __builtin_amdgcn_exp2f(-1.4426950408889634f * g)) * u; }
struct EpiMoeUp {
    bf16* act; const unsigned* list; const float* rstd; const volatile LAS int* cnt; mutable float rsv[8];
    DI void pre(const Unit& u, int wr, int fr) const { const int n = cnt[u.e]; const int pos0 = u.rb * 256 + wr * 64 + fr;
#pragma unroll
        for (int q = 0; q < 8; ++q) { int pos = pos0 + (q >> 2) * 128 + (q & 3) * 16; pos = pos < n ? pos : 0; rsv[q] = rstd[(size_t)u.e * CAP + pos]; } }
    DI void operator()(const Acc& acc, const Unit& u, int wr, int wc, int fr, int fq) const {
        const int row0 = u.pm * 256 + wr * 64 + fr; const int col0 = (u.pn & 3) * 128 + wc * 32 + 8 * fq;
        const int n = cnt[u.e]; const int pos0 = u.rb * 256 + wr * 64 + fr;
#pragma unroll
        for (int ai = 0; ai < 2; ++ai)
#pragma unroll
            for (int m = 0; m < 4; ++m) {
                const float rs = rsv[ai * 4 + m];
                f32x4 a0, a1;
#pragma unroll
                for (int j = 0; j < 4; ++j) { a0[j] = silu_mul(acc[ai][0][m][0][j] * rs, acc[ai][1][m][0][j] * rs); a1[j] = silu_mul(acc[ai][0][m][1][j] * rs, acc[ai][1][m][1][j] * rs); }
                st16(act + (size_t)(row0 + ai * 128 + m * 16) * DE + col0, pack8(a0, a1));
            }
    }
};
struct EpiMoeDown {
    bf16* Y; const unsigned* list; const unsigned* gate; const volatile LAS int* cnt; mutable unsigned tkv[8];
    DI void finish() const {}
    DI void pre(const Unit& u, int wr, int fr) const { const int n = cnt[u.e]; const int pos0 = u.rb * 256 + wr * 64 + fr;
#pragma unroll
        for (int q = 0; q < 8; ++q) { int pos = pos0 + (q >> 2) * 128 + (q & 3) * 16; pos = pos < n ? pos : 0; tkv[q] = gate[(size_t)u.e * CAP + pos]; } }
    DI void operator()(const Acc& acc, const Unit& u, int wr, int wc, int fr, int fq) const {
        const int n = cnt[u.e]; const int pos0 = u.rb * 256 + wr * 64 + fr; const int col0 = (u.pn & 3) * 256 + wc * 32 + 8 * fq;
#pragma unroll
        for (int ai = 0; ai < 2; ++ai)
#pragma unroll
            for (int m = 0; m < 4; ++m) {
                const int pos = pos0 + ai * 128 + m * 16;
                if (pos >= n) continue;
                const unsigned tokk = tkv[ai * 4 + m] & 0x1ffffu; const float g = (float)(tkv[ai * 4 + m] >> 17) * (1.0f / 32767.0f);
                bf16* rowp = Y + ((size_t)(tokk & 1u) * MP + (tokk >> 1)) * D + col0;
#pragma unroll
                for (int bj = 0; bj < 2; ++bj) st16(rowp + bj * 128, pack8(acc[ai][bj][m][0] * g, acc[ai][bj][m][1] * g));
            }
    }
};
DI unsigned pk4_fp8(const f32x4& v) { int w = __builtin_amdgcn_cvt_pk_fp8_f32(v[0], v[1], 0, false); w = __builtin_amdgcn_cvt_pk_fp8_f32(v[2], v[3], w, true); return (unsigned)w; }
DI unsigned quad_tr(unsigned w, unsigned sel) {
    const unsigned x0 = (unsigned)__builtin_amdgcn_mov_dpp((int)w, 0x00, 0xf, 0xf, true), x1 = (unsigned)__builtin_amdgcn_mov_dpp((int)w, 0x55, 0xf, 0xf, true);
    const unsigned x2 = (unsigned)__builtin_amdgcn_mov_dpp((int)w, 0xaa, 0xf, 0xf, true), x3 = (unsigned)__builtin_amdgcn_mov_dpp((int)w, 0xff, 0xf, 0xf, true);
    return __builtin_amdgcn_perm(x1, x0, sel) | (__builtin_amdgcn_perm(x3, x2, sel) << 16);
}
struct EpiQKV {
    unsigned char* Q8; unsigned char* K8; unsigned char* V8; const float* rope; const float* rstd; mutable float rsv[8];
    DI void pre(const Unit& u, int wr, int fr) const {
#pragma unroll
        for (int q = 0; q < 8; ++q) rsv[q] = rstd[u.pm * 256 + wr * 64 + fr + (q >> 2) * 128 + (q & 3) * 16];
    }
    DI void operator()(const Acc& acc, const Unit& u, int wr, int wc, int fr, int fq) const {
        const int sec = u.pn >> 2;
        const int row0 = u.pm * 256 + wr * 64 + fr; const int colt = (u.pn & 3) * 256 + wc * 32 + 8 * fq;
        const bool rotw = (sec < 2) && ((wc & 1) == 0);
        const float sc = sec == 0 ? QSCALE : 1.0f;
        const float sg = (fq == 0) ? -1.0f : 1.0f;
        const float* rp = rope + (size_t)(NMETA + (row0 & (SEQ - 1))) * 16;
        f32x4 cs0 = *(const f32x4*)rp, cs1 = *(const f32x4*)(rp + 4), sn0 = *(const f32x4*)(rp + 8), sn1 = *(const f32x4*)(rp + 12);
        const float* st = rope + (size_t)(SEQ + NMETA) * 16;
        unsigned keep[2][2] = {{0u, 0u}, {0u, 0u}};
        int fr_ = fr, fq_ = fq; asm volatile("" : "+v"(fr_), "+v"(fq_));
        const unsigned sel = (unsigned)(fr_ & 3) * 0x0101u + 0x0c0c0400u;
        unsigned char* const obase = sec == 0 ? Q8 : (sec == 1 ? K8 : V8);
        const unsigned lpart = sec == 0 ? (unsigned)(fr_ * D + 8 * fq_) : sec == 1 ? (unsigned)((fq_ >> 1) * 1024 + fr_ * 16 + 8 * (fq_ & 1)) : (unsigned)(((fr_ >> 2) & 1) * 512 + (8 * fq_ + (fr_ & 3)) * 16 + 8 * (fr_ >> 3));
#pragma unroll
        for (int ai = 0; ai < 2; ++ai)
#pragma unroll
            for (int m = 0; m < 4; ++m) {
                const int r = row0 + ai * 128 + m * 16; const float rs = rsv[ai * 4 + m];
                if (rotw && (ai | m) != 0) {
                    const float* sp = st + ((m == 0) ? 16 : 0);
                    const f32x4 dc0 = *(const f32x4*)sp, dc1 = *(const f32x4*)(sp + 4), ds0 = *(const f32x4*)(sp + 8), ds1 = *(const f32x4*)(sp + 12);
                    const f32x4 nc0 = cs0 * dc0 - sn0 * ds0, nc1 = cs1 * dc1 - sn1 * ds1;
                    sn0 = sn0 * dc0 + cs0 * ds0; sn1 = sn1 * dc1 + cs1 * ds1; cs0 = nc0; cs1 = nc1;
                }
#pragma unroll
                for (int bj = 0; bj < 2; ++bj) {
                    f32x4 v0 = acc[ai][bj][m][0] * rs, v1 = acc[ai][bj][m][1] * rs;
                    if (rotw) {
                        f32x4 p0, p1;
#pragma unroll
                        for (int j = 0; j < 4; ++j) { p0[j] = xrow16(v0[j], fq); p1[j] = xrow16(v1[j], fq); }
                        if (fq < 2) { v0 = v0 * cs0 + p0 * sn0 * sg; v1 = v1 * cs1 + p1 * sn1 * sg; }
                    }
                    v0 = v0 * sc; v1 = v1 * sc;
                    const size_t timg = ((size_t)((u.pm * 4 + ai * 2 + wr) * 8 + (u.pn & 3) * 2 + bj)) * 8192;
                    if (sec == 0) *(u32x2*)(obase + ((size_t)(u.pm * 256 + wr * 64 + ai * 128 + m * 16) * D + (u.pn & 3) * 256 + wc * 32 + bj * 128) + lpart) = (u32x2){pk4_fp8(v0), pk4_fp8(v1)};
                    else if (sec == 1) *(u32x2*)(obase + (timg + (wc >> 1) * 4096 + (m >> 1) * 2048 + (wc & 1) * 512 + (m & 1) * 256) + lpart) = (u32x2){pk4_fp8(v0), pk4_fp8(v1)};
                    else {
                        const unsigned tlo = quad_tr(pk4_fp8(v0), sel), thi = quad_tr(pk4_fp8(v1), sel);
                        if ((m & 1) == 0) { keep[bj][0] = tlo; keep[bj][1] = thi; }
                        else {
                            unsigned char* img = obase + (timg + (m >> 1) * 4096 + wc * 1024) + lpart;
                            *(u32x2*)img = (u32x2){keep[bj][0], tlo}; *(u32x2*)(img + 64) = (u32x2){keep[bj][1], thi};
                        }
                    }
                }
            }
    }
};

DI f32x4 meta_tile(const bf16* A16, int lda, const bf16* Bt16, int K, int lane) {
    const int r = lane & 15, kq = lane >> 4; f32x4 acc = {0.f, 0.f, 0.f, 0.f};
    const bf16* ap = A16 + (size_t)r * lda + 8 * kq; const bf16* bp = Bt16 + (size_t)r * K + 8 * kq;
#pragma unroll 8
    for (int k0 = 0; k0 < K; k0 += 32) { const bf16x8 a = *(const bf16x8*)(ap + k0), b = *(const bf16x8*)(bp + k0); acc = __builtin_amdgcn_mfma_f32_16x16x32_bf16(a, b, acc, 0, 0, 0); }
    return acc;
}
DI bf16 f2bf(float v) { return (bf16)(cvtpk(v, 0.f) & 0xffffu); }

namespace att {
constexpr int SLOT = 16384, KOFF = 0, VOFF = 8192, NSLOT = 4, WS_OFF = NSLOT * SLOT, Q1_OFF = WS_OFF + NWAVES * 256, ATT_LDS = Q1_OFF + NWAVES * 4096;
static_assert(ATT_LDS <= MISC_OFF, "attention LDS");
DI int crow(int r, int hi) { return (r & 3) + 8 * (r >> 2) + 4 * hi; }
typedef int v8i32_t __attribute__((ext_vector_type(8)));
DI float xhalf_max(float m) { auto rr = __builtin_amdgcn_permlane32_swap(__float_as_uint(m), __float_as_uint(m), false, false); return __builtin_fmaxf(__uint_as_float(rr[0]), __uint_as_float(rr[1])); }
DI float xhalf_sum(float m) { auto rr = __builtin_amdgcn_permlane32_swap(__float_as_uint(m), __float_as_uint(m), false, false); return __uint_as_float(rr[0]) + __uint_as_float(rr[1]); }
#define MFMA8(a, b, c) __builtin_amdgcn_mfma_scale_f32_32x32x64_f8f6f4((a), (b), (c), 0, 0, 0, 0, 0, 0)
#define ATT_WAIT_BAR(N) asm volatile("s_waitcnt vmcnt(" #N ") lgkmcnt(0)\n\ts_barrier" ::: "memory")
DI void glds16(const void* sbase, unsigned voff, unsigned lds_dst) { unsigned keep;
    asm volatile("s_mov_b32 %0, m0\n\ts_mov_b32 m0, %3\n\ts_nop 0\n\tglobal_load_lds_dwordx4 %1, %2\n\ts_mov_b32 m0, %0" : "=&s"(keep) : "v"(voff), "s"(sbase), "s"(lds_dst) : "memory"); }
template <bool SAFE>
DI bool attn_unit(int b, int h, int qb, const unsigned char* Q8, const unsigned char* K8, const unsigned char* V8, bf16* O, float lam, const float* subg, LAS char* shm) {
    int tid_ = threadIdx.x; asm volatile("" : "+v"(tid_));
    const int tid = tid_, lane = tid & 63, r = lane & 31, hh = lane >> 5; const int wid = __builtin_amdgcn_readfirstlane(tid >> 6);
    const int q0 = qb * 256; const int qrow0 = b * SEQ + q0 + wid * 32;
    const int NT = 4 * qb + 5;
    const int NTw = ((q0 + wid * 32) >> 6) + 2;
    const unsigned lds0 = (unsigned)(uintptr_t)shm;
    LAS float* wsf = (LAS float*)(shm + WS_OFF) + wid * 64;
    const unsigned char* K8h = K8 + (size_t)h * 8192 + (size_t)wid * 1024; const unsigned char* V8h = V8 + (size_t)h * 8192 + (size_t)wid * 1024;
#define ATT_DMA(t, slot) do { const int trow_ = ((t) == 0) ? TR : (b * SEQ + ((t) - 1) * 64); const size_t to_ = (size_t)(trow_ >> 6) * 65536; const unsigned sb_ = lds0 + (unsigned)(slot) + (unsigned)wid * 1024u; \
        glds16(K8h + to_, (unsigned)lane * 16u, (unsigned)__builtin_amdgcn_readfirstlane(sb_ + KOFF)); glds16(V8h + to_, (unsigned)lane * 16u, (unsigned)__builtin_amdgcn_readfirstlane(sb_ + VOFF)); } while (0)
    f32x16 o[2][4];
#pragma unroll
    for (int n = 0; n < 2; ++n)
#pragma unroll
        for (int d = 0; d < 4; ++d)
#pragma unroll
            for (int i = 0; i < 16; ++i) o[n][d][i] = 0.f;
    float mrun[2] = {0.f, 0.f}, lrun[2] = {0.f, 0.f};
    f32x4 ls0 = {0.f, 0.f, 0.f, 0.f}, ls1 = ls0;
    typedef int v4i32_t __attribute__((ext_vector_type(4)));
    const int onew = ((((lane & 15) == 0) && ((lane >> 4) & 1) == 0) || (((lane & 15) == 1) && ((lane >> 4) & 1) == 1)) ? 0x22222222 : 0;
    v4i32_t ones4 = {onew, onew, onew, onew}; asm volatile("" : "+v"(ones4));
    ATT_DMA(0, 0); ATT_DMA(1, SLOT); ATT_DMA(2, 2 * SLOT);
    const LAS char* q1 = shm + Q1_OFF + wid * 4096 + lane * 16;
    {
        const unsigned qoff = (unsigned)(r * D + hh * 32); const unsigned char* Qw = Q8 + (size_t)qrow0 * D + h * 128;
        const unsigned qdst = lds0 + Q1_OFF + (unsigned)wid * 4096u;
#pragma unroll
        for (int ms = 0; ms < 4; ++ms) glds16(Qw + (ms >> 1) * 64 + (ms & 1) * 16, qoff, (unsigned)__builtin_amdgcn_readfirstlane(qdst + ms * 1024));
    }
    ATT_WAIT_BAR(0);
#define SB() __builtin_amdgcn_sched_barrier(0)
#define RD8(dst, P, PL) do { const u32x4 lo_ = *(const LAS u32x4*)(P), hi_ = *(const LAS u32x4*)((P) + (PL)); dst = (v8i32_t){(int)lo_[0], (int)lo_[1], (int)lo_[2], (int)lo_[3], (int)hi_[0], (int)hi_[1], (int)hi_[2], (int)hi_[3]}; } while (0)
#define ATT_SM8(S, NC, MASKED, PA, O4) do { \
        if ((MASKED) < 32) { asm volatile("; meta-tile mask" ::: "memory"); _Pragma("unroll") for (int i_ = 0; i_ < 16; ++i_) { if (crow(i_, hh) >= (MASKED)) S[i_] = -INFINITY; } } \
        if (SAFE) { \
            float mx_ = __builtin_fmaxf(__builtin_fmaxf(S[0], S[1]), S[2]); \
            _Pragma("unroll") for (int i_ = 3; i_ < 15; i_ += 2) mx_ = __builtin_fmaxf(__builtin_fmaxf(mx_, S[i_]), S[i_ + 1]); \
            mx_ = __builtin_fmaxf(mx_, S[15]); mx_ = xhalf_max(mx_); \
            const bool grow_ = mx_ > mrun[NC] + 8.0f; \
            if (__any(grow_)) { const float mnew_ = grow_ ? mx_ : mrun[NC]; const float f_ = __builtin_amdgcn_exp2f(mrun[NC] - mnew_); mrun[NC] = mnew_; lrun[NC] *= f_; \
                if (hh == 0) wsf[r] = f_; LDS_WAIT(); \
                _Pragma("unroll") for (int g_ = 0; g_ < 4; ++g_) { const f32x4 fv_ = *(const LAS f32x4*)(wsf + 8 * g_ + 4 * hh); \
                    _Pragma("unroll") for (int d_ = 0; d_ < 4; ++d_) _Pragma("unroll") for (int j_ = 0; j_ < 4; ++j_) o[NC][d_][4 * g_ + j_] *= fv_[j_]; } \
                LDS_WAIT(); } \
            const float mm_ = mrun[NC]; \
            _Pragma("unroll") for (int i_ = 0; i_ < 16; ++i_) S[i_] = S[i_] - mm_; \
        } \
        { float ls_ = 0.f; \
          _Pragma("unroll") for (int g_ = 0; g_ < 4; ++g_) { const int i0_ = 4 * (((g_ & 1) << 1) | (g_ >> 1)); \
              const float e0_ = __builtin_amdgcn_exp2f(S[i0_]), e1_ = __builtin_amdgcn_exp2f(S[i0_ + 1]), e2_ = __builtin_amdgcn_exp2f(S[i0_ + 2]), e3_ = __builtin_amdgcn_exp2f(S[i0_ + 3]); \
              ls_ += (e0_ + e1_) + (e2_ + e3_); int w_ = __builtin_amdgcn_cvt_pk_fp8_f32(e0_, e1_, 0, false); w_ = __builtin_amdgcn_cvt_pk_fp8_f32(e2_, e3_, w_, true); PA[(O4) + g_] = w_; \
              if (g_ == 1) SB(); } \
          lrun[NC] += ls_; } \
    } while (0)
#define ATT_QS8(KC, MASKED, O4, VPRE) do { \
        f32x16 S_; v8i32_t ka_, qa_, kb_, qb_; \
        _Pragma("unroll") for (int i_ = 0; i_ < 16; ++i_) S_[i_] = SAFE ? 0.f : -2.0f; \
        RD8(ka_, KC, 1024); RD8(qa_, q1, 1024); SB(); \
        RD8(kb_, (KC) + 4096, 1024); RD8(qb_, q1 + 2048, 1024); SB(); \
        S_ = MFMA8(ka_, qa_, S_); SB(); \
        ATT_SM8(S_, 0, MASKED, pa_, O4); SB(); \
        _Pragma("unroll") for (int i_ = 0; i_ < 16; ++i_) S_[i_] = SAFE ? 0.f : -2.0f; \
        if (VPRE) { RD8(va8_, v8c, 4096); RD8(vb8_, v8c + 1024, 4096); } SB(); \
        S_ = MFMA8(kb_, qb_, S_); SB(); \
        ATT_SM8(S_, 1, MASKED, pb_, O4); SB(); \
    } while (0)
#define ATT_SM8H(S, NC, MASKED, PA, O4, H) do { \
        if ((H) == 0 && (MASKED) < 32) { asm volatile("; meta-tile mask" ::: "memory"); _Pragma("unroll") for (int i_ = 0; i_ < 16; ++i_) { if (crow(i_, hh) >= (MASKED)) S[i_] = -INFINITY; } } \
        { const int ia_ = 4 * (((2 * (H)) & 1) << 1 | ((2 * (H)) >> 1)), ib_ = 4 * ((((2 * (H) + 1) & 1) << 1) | ((2 * (H) + 1) >> 1)); \
          const float e0_ = __builtin_amdgcn_exp2f(S[ia_]), e1_ = __builtin_amdgcn_exp2f(S[ia_ + 1]), e2_ = __builtin_amdgcn_exp2f(S[ia_ + 2]), e3_ = __builtin_amdgcn_exp2f(S[ia_ + 3]); \
          const float f0_ = __builtin_amdgcn_exp2f(S[ib_]), f1_ = __builtin_amdgcn_exp2f(S[ib_ + 1]), f2_ = __builtin_amdgcn_exp2f(S[ib_ + 2]), f3_ = __builtin_amdgcn_exp2f(S[ib_ + 3]); \
          int wa_ = __builtin_amdgcn_cvt_pk_fp8_f32(e0_, e1_, __float_as_int(e0_), false); wa_ = __builtin_amdgcn_cvt_pk_fp8_f32(e2_, e3_, wa_, true); \
          int wb_ = __builtin_amdgcn_cvt_pk_fp8_f32(f0_, f1_, __float_as_int(f0_), false); wb_ = __builtin_amdgcn_cvt_pk_fp8_f32(f2_, f3_, wb_, true); \
          asm volatile("" : "+v"(wa_), "+v"(wb_)); PA[(O4) + 2 * (H)] = wa_; PA[(O4) + 2 * (H) + 1] = wb_; } \
    } while (0)
#define ATT_QKASM(SD, KF, QF) asm volatile("v_mfma_f32_32x32x64_f8f6f4 %0, %1, %2, -2.0" : "=&v"(SD) : "v"(KF), "v"(QF))
#define ATT_QKASM_S(SD, KF, QF, SP) asm volatile("v_mfma_f32_32x32x64_f8f6f4 %0, %2, %3, -2.0" : "=&v"(SD), "+v"(SP) : "v"(KF), "v"(QF))
#define ATT_PVASM(OACC, PP, VF) asm volatile("s_nop 1\n\tv_mfma_f32_32x32x64_f8f6f4 %0, %1, %2, %0" : "+v"(OACC) : "v"(PP), "v"(VF))
#define ATT_PVASM_S(OACC, PP, VF, SD) asm volatile("s_nop 1\n\tv_mfma_f32_32x32x64_f8f6f4 %0, %2, %3, %0" : "+v"(OACC), "+v"(SD) : "v"(PP), "v"(VF))
#define ATT_SUMASM(LACC, PP) asm volatile("v_mfma_f32_16x16x128_f8f6f4 %0, %1, %2, %0 blgp:4" : "+v"(LACC) : "v"(PP), "v"(ones4))
#define ATT_PIECE(S, G, PA, O4) do { const int i0_ = 4 * ((((G) & 1) << 1) | ((G) >> 1)); \
        const float e0_ = __builtin_amdgcn_exp2f(S[i0_]), e1_ = __builtin_amdgcn_exp2f(S[i0_ + 1]), e2_ = __builtin_amdgcn_exp2f(S[i0_ + 2]), e3_ = __builtin_amdgcn_exp2f(S[i0_ + 3]); \
        int w_ = __builtin_amdgcn_cvt_pk_fp8_f32(e0_, e1_, __float_as_int(e0_), false); w_ = __builtin_amdgcn_cvt_pk_fp8_f32(e2_, e3_, w_, true); \
        asm volatile("" : "+v"(w_)); PA[(O4) + (G)] = w_; } while (0)
#define ATT_PBLK(SC, SN, PA, O4, DB, KQLOAD, VLOAD, EXTRA) do { \
        ATT_PVASM_S(o[0][DB], pa_p, va8_, SC); \
        ATT_PIECE(SC, 0, PA, O4); \
        ATT_QKASM_S(SN, kf_, qf_, SC); KQLOAD; \
        ATT_PIECE(SC, 1, PA, O4); \
        ATT_PVASM_S(o[1][DB], pb_p, va8_, SC); VLOAD; \
        ATT_PIECE(SC, 2, PA, O4); \
        EXTRA; \
        ATT_PIECE(SC, 3, PA, O4); \
    } while (0)
#define ATT_DRAIN(VP) do { v8i32_t va8_, vb8_; RD8(va8_, VP, 4096); RD8(vb8_, (VP) + 1024, 4096); SB(); \
        o[0][0] = MFMA8(pa_p, va8_, o[0][0]); o[1][0] = MFMA8(pb_p, va8_, o[1][0]); RD8(va8_, (VP) + 2048, 4096); SB(); \
        o[0][1] = MFMA8(pa_p, vb8_, o[0][1]); o[1][1] = MFMA8(pb_p, vb8_, o[1][1]); RD8(vb8_, (VP) + 3072, 4096); SB(); \
        o[0][2] = MFMA8(pa_p, va8_, o[0][2]); o[1][2] = MFMA8(pb_p, va8_, o[1][2]); \
        o[0][3] = MFMA8(pa_p, vb8_, o[0][3]); o[1][3] = MFMA8(pb_p, vb8_, o[1][3]); SB(); ATT_SUMASM(ls0, pa_p); ATT_SUMASM(ls1, pb_p); } while (0)
    int so_c = 0;
#define SO_PREV(c) (((c) - SLOT) & (NSLOT * SLOT - 1))
#define SO_NEXT(c) (((c) + SLOT) & (NSLOT * SLOT - 1))
#define ATT_TILE_END(t) do { if ((t) + 1 < NT) { ATT_WAIT_BAR(0); if ((t) + 3 < NT) { ATT_DMA((t) + 3, SO_PREV(so_c)); } } so_c = SO_NEXT(so_c); } while (0)
    if (SAFE) {
#pragma unroll 1
        for (int t = 0; t < NT; ++t) {
            if (t < NTw) {
                const LAS char* kc = shm + so_c + KOFF + lane * 16; const LAS char* v8c = shm + so_c + VOFF + lane * 16;
                const int kv0 = (t == 0) ? 16 : 32, kv1 = (t == 0) ? 0 : 32;
                v8i32_t pa_, pb_, va8_, vb8_;
                ATT_QS8(kc, kv0, 0, false); ATT_QS8(kc + 2048, kv1, 4, true);
                o[0][0] = MFMA8(pa_, va8_, o[0][0]); o[1][0] = MFMA8(pb_, va8_, o[1][0]); RD8(va8_, v8c + 2048, 4096); SB();
                o[0][1] = MFMA8(pa_, vb8_, o[0][1]); o[1][1] = MFMA8(pb_, vb8_, o[1][1]); RD8(vb8_, v8c + 3072, 4096); SB();
                o[0][2] = MFMA8(pa_, va8_, o[0][2]); o[1][2] = MFMA8(pb_, va8_, o[1][2]);
                o[0][3] = MFMA8(pa_, vb8_, o[0][3]); o[1][3] = MFMA8(pb_, vb8_, o[1][3]); SB();
            }
            ATT_TILE_END(t);
        }
    } else {
        v8i32_t pa_p = {0, 0, 0, 0, 0, 0, 0, 0}, pb_p = {0, 0, 0, 0, 0, 0, 0, 0};
        {
            const LAS char* kc = shm + KOFF + lane * 16; v8i32_t ka_, kb_, qa_, qb_; f32x16 S_;
            RD8(ka_, kc, 1024); RD8(qa_, q1, 1024); RD8(kb_, kc + 4096, 1024); RD8(qb_, q1 + 2048, 1024); SB();
            ATT_QKASM(S_, ka_, qa_); asm volatile("s_nop 15\n\ts_nop 3" : "+v"(S_));
            ATT_SM8H(S_, 0, 16, pa_p, 0, 0); ATT_SM8H(S_, 0, 16, pa_p, 0, 1);
            ATT_QKASM(S_, kb_, qb_); asm volatile("s_nop 15\n\ts_nop 3" : "+v"(S_));
            ATT_SM8H(S_, 1, 16, pb_p, 0, 0); ATT_SM8H(S_, 1, 16, pb_p, 0, 1);
            ATT_TILE_END(0);
        }
        f32x16 S0, S1; v8i32_t kf_, qf_, va8_;
        {   const LAS char* k1 = shm + SLOT + KOFF + lane * 16;
            RD8(kf_, k1, 1024); RD8(qf_, q1, 1024);
            ATT_QKASM(S0, kf_, qf_); asm volatile("s_nop 15\n\ts_nop 3" : "+v"(S0));
            RD8(kf_, k1 + 4096, 1024); RD8(qf_, q1 + 2048, 1024); RD8(va8_, shm + VOFF + lane * 16, 4096); }
#pragma unroll 1
        for (int t = 1; t < NTw; ++t) {
            const LAS char* v8p = shm + SO_PREV(so_c) + VOFF + lane * 16; const LAS char* kc = shm + so_c + KOFF + lane * 16; const LAS char* kn = shm + SO_NEXT(so_c) + KOFF + lane * 16;
            v8i32_t pa_, pb_;
            ATT_PBLK(S0, S1, pa_, 0, 0, RD8(kf_, kc + 2048, 1024); RD8(qf_, q1, 1024), RD8(va8_, v8p + 1024, 4096), ATT_SUMASM(ls0, pa_p));
            ATT_PBLK(S1, S0, pb_, 0, 1, RD8(kf_, kc + 2048 + 4096, 1024); RD8(qf_, q1 + 2048, 1024), RD8(va8_, v8p + 2048, 4096), ATT_SUMASM(ls1, pb_p));
            ATT_PBLK(S0, S1, pa_, 4, 2, RD8(kf_, kn, 1024); RD8(qf_, q1, 1024), RD8(va8_, v8p + 3072, 4096), (void)0);
            ATT_PBLK(S1, S0, pb_, 4, 3, RD8(kf_, kn + 4096, 1024); RD8(qf_, q1 + 2048, 1024), RD8(va8_, shm + so_c + VOFF + lane * 16, 4096), (void)0);
            pa_p = pa_; pb_p = pb_;
            ATT_TILE_END(t);
        }
        { const LAS char* v8p = shm + SO_PREV(so_c) + VOFF + lane * 16; ATT_DRAIN(v8p); }
#pragma unroll 1
        for (int t = NTw; t < NT; ++t) ATT_TILE_END(t);
    }
#undef ATT_TILE_END
#undef SO_NEXT
#undef SO_PREV
#undef ATT_DRAIN
#undef ATT_PBLK
#undef ATT_PVASM
#undef ATT_PVASM_S
#undef ATT_PIECE
#undef ATT_SUMASM
#undef ATT_QKASM
#undef ATT_QKASM_S
#undef ATT_SM8H
#undef ATT_QS8
#undef ATT_SM8
#undef RD8
#undef SB
    bool bad = false;
    if (SAFE) { const float l0 = xhalf_sum(lrun[0]), l1 = xhalf_sum(lrun[1]);
        if (hh == 0) { wsf[r] = __builtin_amdgcn_rcpf(l0); wsf[32 + r] = lam * __builtin_amdgcn_rcpf(l1); }
    } else {
        asm volatile("s_nop 15\n\ts_nop 3" : "+v"(ls0), "+v"(ls1));
        const bool own = (lane & 15) < 2; const float thr = 0.1f * (float)(16 + 64 * (NTw - 1));
        const float lmin = __builtin_fminf(__builtin_fminf(__builtin_fminf(ls0[0], ls0[1]), __builtin_fminf(ls0[2], ls0[3])), __builtin_fminf(__builtin_fminf(ls1[0], ls1[1]), __builtin_fminf(ls1[2], ls1[3])));
        bool ok = lmin > thr;
#pragma unroll
        for (int i = 0; i < 4; ++i) ok = ok && (ls0[i] == ls0[i]) && (ls1[i] == ls1[i]);
        bad = __any(own && !ok);
        if (own) { const int qb_ = 16 * (lane & 15) + 4 * (lane >> 4);
#pragma unroll
            for (int i = 0; i < 4; ++i) { wsf[qb_ + i] = __builtin_amdgcn_rcpf(ls0[i]); wsf[32 + qb_ + i] = lam * __builtin_amdgcn_rcpf(ls1[i]); } }
    }
    LDS_WAIT();
    float gsub[4];
#pragma unroll
    for (int d = 0; d < 4; ++d) gsub[d] = subg[32 * d + r];
    int r_o = r; asm volatile("" : "+v"(r_o));
    bf16* Ow = O + (size_t)qrow0 * D + h * 128 + r_o;
#pragma unroll
    for (int g = 0; g < 4; ++g) { const f32x4 c0 = *(const LAS f32x4*)(wsf + 8 * g + 4 * hh), c1 = *(const LAS f32x4*)(wsf + 32 + 8 * g + 4 * hh);
#pragma unroll
        for (int j = 0; j < 4; ++j) { float ssq = 0.f; float y[4];
#pragma unroll
            for (int d = 0; d < 4; ++d) { y[d] = o[0][d][4 * g + j] * c0[j] - o[1][d][4 * g + j] * c1[j]; ssq += y[d] * y[d]; }
#define DPP_ADD(v, ctrl) ((v) + __int_as_float(__builtin_amdgcn_mov_dpp(__float_as_int(v), (ctrl), 0xf, 0xf, true)))
            ssq = DPP_ADD(ssq, 0xB1); ssq = DPP_ADD(ssq, 0x4E); ssq = DPP_ADD(ssq, 0x141); ssq = DPP_ADD(ssq, 0x140);
            ssq += xrow16(ssq, lane >> 4);
#undef DPP_ADD
            const float sc = (1.0f - LAM_INIT) * __builtin_amdgcn_rsqf(ssq * (1.0f / 128.0f) + EPS);
            const int orow = crow(4 * g + j, hh);
#pragma unroll
            for (int d = 0; d < 4; ++d) Ow[(size_t)orow * D + 32 * d] = (bf16)(cvtpk(y[d] * sc * gsub[d], 0.f) & 0xffffu); } }
    asm volatile("s_waitcnt vmcnt(0) lgkmcnt(0)\n\ts_barrier" ::: "memory");
#undef ATT_DMA
    return bad;
}
DI void attn_unit_checked(int b, int h, int qb, const unsigned char* Q8, const unsigned char* K8, const unsigned char* V8, bf16* O, float lam, const float* subg, LAS char* shm, volatile LAS unsigned* flag) {
    const bool bad = attn_unit<false>(b, h, qb, Q8, K8, V8, O, lam, subg, shm);
    if (bad && (threadIdx.x & 63) == 0) flag[0] = 1u;
    asm volatile("s_waitcnt lgkmcnt(0)\n\ts_barrier" ::: "memory");
    const unsigned redo = flag[0];
    asm volatile("s_waitcnt lgkmcnt(0)\n\ts_barrier" ::: "memory");
    if (redo) { if (threadIdx.x == 0) flag[0] = 0u; (void)attn_unit<true>(b, h, qb, Q8, K8, V8, O, lam, subg, shm); }
}
}

struct Frame {
    LAS unsigned char* lds; volatile LAS unsigned* MISC; unsigned* ctl;
    int tid, lane, wave, vcu, G;
    unsigned char* ws;
};
struct TItem { const float* W; bf16* WT; const float* gain; int K, N, k0, n0, drow0; };
DI void titem_load(const TItem& it, f32x4 (&v)[16], int lane) {
    const float* p = it.W + (size_t)(it.k0 + 16 * (lane >> 4)) * it.N + it.n0 + 4 * (lane & 15);
#pragma unroll
    for (int j = 0; j < 16; ++j) v[j] = __builtin_nontemporal_load((const f32x4*)(p + (size_t)j * it.N));
}
DI void titem_store(const TItem& it, f32x4 (&v)[16], int lane) {
    if (it.gain) { const f32x4* g = (const f32x4*)(it.gain + it.k0 + 16 * (lane >> 4));
#pragma unroll
        for (int q = 0; q < 4; ++q) { const f32x4 gv = g[q];
#pragma unroll
            for (int i = 0; i < 4; ++i) v[4 * q + i] = v[4 * q + i] * gv[i]; } }
    bf16* o = it.WT + (size_t)(it.drow0 + 4 * (lane & 15)) * it.K + it.k0 + 16 * (lane >> 4);
#pragma unroll
    for (int c = 0; c < 4; ++c) { u32x4 w0, w1;
        w0.x = cvtpk(v[0][c], v[1][c]); w0.y = cvtpk(v[2][c], v[3][c]); w0.z = cvtpk(v[4][c], v[5][c]); w0.w = cvtpk(v[6][c], v[7][c]);
        w1.x = cvtpk(v[8][c], v[9][c]); w1.y = cvtpk(v[10][c], v[11][c]); w1.z = cvtpk(v[12][c], v[13][c]); w1.w = cvtpk(v[14][c], v[15][c]);
        *(u32x4*)(o + (size_t)c * it.K) = w0; *(u32x4*)(o + (size_t)c * it.K + 8) = w1; }
}
DI TItem expert_item(int it, const float* eg, const float* eu, const float* ed, const float* gain, bf16* EGUp, bf16* EDp) {
    constexpr int IPE = 128;
    const int e = it / (3 * IPE), r = it % (3 * IPE), mat = r / IPE, q = r % IPE; TItem t;
    if (mat < 2) { const int kb = q / 8, nb = q % 8, n0 = nb * 64;
        t.W = (mat == 0 ? eg : eu) + (size_t)e * D * DE; t.WT = EGUp + (size_t)e * 1024 * D; t.gain = gain; t.K = D; t.N = DE; t.k0 = kb * 64; t.n0 = n0; t.drow0 = (n0 >> 7) * 256 + mat * 128 + (n0 & 127);
    } else { const int kb = q / 16, nb = q % 16;
        t.W = ed + (size_t)e * DE * D; t.WT = EDp + (size_t)e * D * DE; t.gain = nullptr; t.K = DE; t.N = D; t.k0 = kb * 64; t.n0 = nb * 64; t.drow0 = nb * 64; }
    return t;
}
DI void convert_experts(Frame& F, const float* eg, const float* eu, const float* ed, const float* gain, bf16* EGUp, bf16* EDp, int kbeg = 0, int kend = 1024) {
    const int gw_ = F.vcu * NWAVES + F.wave, NGW_ = F.G * NWAVES; const int NIT = min(32 * 3 * 128, kend * NGW_);
    f32x4 va[16], vb[16];
    int it = gw_ + kbeg * NGW_;
    if (it < NIT) { TItem ta = expert_item(it, eg, eu, ed, gain, EGUp, EDp); titem_load(ta, va, F.lane); }
    for (; it < NIT; it += 2 * NGW_) {
        const int it2 = it + NGW_, it3 = it + 2 * NGW_;
        if (it2 < NIT) { TItem tb = expert_item(it2, eg, eu, ed, gain, EGUp, EDp); titem_load(tb, vb, F.lane); }
        { TItem ta = expert_item(it, eg, eu, ed, gain, EGUp, EDp); titem_store(ta, va, F.lane); }
        if (it3 < NIT) { TItem ta = expert_item(it3, eg, eu, ed, gain, EGUp, EDp); titem_load(ta, va, F.lane); }
        if (it2 < NIT) { TItem tb = expert_item(it2, eg, eu, ed, gain, EGUp, EDp); titem_store(tb, vb, F.lane); }
    }
}
DI void expjob_item(const ExpJob& J, int k, int lane) {
    const int it = J.gw + k * J.ngw; if (it >= 32 * 3 * 128) return;
    const TItem t = expert_item(it, J.eg, J.eu, J.ed, J.gain, J.EGUp, J.EDp); f32x4 v[16]; titem_load(t, v, lane); titem_store(t, v, lane);
}
struct P0Src { const float *eg, *eu, *ed, *egain, *w_in, *g_in, *w_out, *w_q, *g_q, *w_kv, *g_kv, *w_o; bf16 *EGUp, *EDp, *WINp, *WOUTp, *WQKVp, *WOp; };
DI TItem dense_item(int it, const P0Src& P) {
    TItem t; t.K = D; int nnb, drow_off = 0, mode = 0;
    if (it < 768) { t.W = P.w_in; t.WT = P.WINp; t.gain = P.g_in; t.N = 3 * D; nnb = 48; mode = 1; }
    else if (it < 1024) { it -= 768; t.W = P.w_out; t.WT = P.WOUTp; t.gain = nullptr; t.N = D; nnb = 16; }
    else if (it < 1280) { it -= 1024; t.W = P.w_q; t.WT = P.WQKVp; t.gain = P.g_q; t.N = D; nnb = 16; }
    else if (it < 1792) { it -= 1280; t.W = P.w_kv; t.WT = P.WQKVp; t.gain = P.g_kv; t.N = 2 * D; nnb = 32; drow_off = D; }
    else { it -= 1792; t.W = P.w_o; t.WT = P.WOp; t.gain = nullptr; t.N = D; nnb = 16; }
    const int kb = it / nnb, nb = it % nnb, n0 = nb * 64; int drow0 = n0 + drow_off;
    if (mode == 1 && n0 >= 1024) { const int ch = (n0 - 1024) & 1023, isu = (n0 >= 2048) ? 1 : 0; drow0 = 1024 + (ch >> 7) * 256 + isu * 128 + (ch & 127); }
    t.k0 = kb * 64; t.n0 = n0; t.drow0 = drow0; return t;
}
DI void p0_convert_all(Frame& F, const P0Src& P) {
    const int gw_ = F.vcu * NWAVES + F.wave, NGW_ = F.G * NWAVES;
    const int KE = P.eg ? (32 * 3 * 128 - gw_ + NGW_ - 1) / NGW_ : 0, KD = (2048 - gw_ + NGW_ - 1) / NGW_, KT = (KE > 0 ? KE : 0) + (KD > 0 ? KD : 0);
#define P0_ITEM(k) (((k) < KE) ? expert_item(gw_ + (k) * NGW_, P.eg, P.eu, P.ed, P.egain, P.EGUp, P.EDp) : dense_item(gw_ + ((k) - KE) * NGW_, P))
    f32x4 va[16], vb[16];
    if (KT > 0) { const TItem t = P0_ITEM(0); titem_load(t, va, F.lane); }
    for (int k = 0; k < KT; k += 2) {
        if (k + 1 < KT) { const TItem t = P0_ITEM(k + 1); titem_load(t, vb, F.lane); }
        { const TItem t = P0_ITEM(k); titem_store(t, va, F.lane); }
        if (k + 2 < KT) { const TItem t = P0_ITEM(k + 2); titem_load(t, va, F.lane); }
        if (k + 1 < KT) { const TItem t = P0_ITEM(k + 1); titem_store(t, vb, F.lane); }
    }
#undef P0_ITEM
}
DI const float* hrow(const float* mainp, const float* metap, int r) { return r < TR ? mainp + (size_t)r * D : metap + (size_t)(r - TR) * D; }
struct Row16 { f32x4 v[4]; };
DI Row16 load_row(const float* p, int lane) { Row16 x; const f32x4* q = (const f32x4*)p + lane;
#pragma unroll
    for (int j = 0; j < 4; ++j) x.v[j] = q[64 * j];
    return x; }
DI float row_sumsq(const Row16& x) { float s = 0.f;
#pragma unroll
    for (int j = 0; j < 4; ++j) s += (x.v[j][0] * x.v[j][0] + x.v[j][1] * x.v[j][1]) + (x.v[j][2] * x.v[j][2] + x.v[j][3] * x.v[j][3]);
    return wave_sum(s); }
DI void store_row_bf16(bf16* p, const Row16& x, float sc, int lane) { u32x2* q = (u32x2*)p + lane;
#pragma unroll
    for (int j = 0; j < 4; ++j) { u32x2 w; w.x = cvtpk(x.v[j][0] * sc, x.v[j][1] * sc); w.y = cvtpk(x.v[j][2] * sc, x.v[j][3] * sc); q[64 * j] = w; } }
struct Row8 { u32x2 w[4]; };
DI Row8 load_row8(const bf16* p, int lane) { Row8 y; const u32x2* q = (const u32x2*)p + lane;
#pragma unroll
    for (int j = 0; j < 4; ++j) y.w[j] = q[64 * j];
    return y; }
DI void add_row8(Row16& x, const Row8& y) {
#pragma unroll
    for (int j = 0; j < 4; ++j) { x.v[j][0] += bflo(y.w[j].x); x.v[j][1] += bfhi(y.w[j].x); x.v[j][2] += bflo(y.w[j].y); x.v[j][3] += bfhi(y.w[j].y); } }
DI void add_row_bf16(Row16& x, const bf16* p, int lane) { const u32x2* q = (const u32x2*)p + lane;
#pragma unroll
    for (int j = 0; j < 4; ++j) { const u32x2 w = q[64 * j]; x.v[j][0] += bflo(w.x); x.v[j][1] += bfhi(w.x); x.v[j][2] += bflo(w.y); x.v[j][3] += bfhi(w.y); } }
DI void route_phase(Frame& F, const bf16* HBp, int nrows, const bf16* RWBp, const float* bg, const float* be, unsigned* cnt, unsigned* list, float* rstd_out, float* rstdp, unsigned* gatep) {
    const int lane = F.lane, row = lane & 15, kq = lane >> 4;
    const int ngroups = (nrows + 15) >> 4;
    LAS float* L = (LAS float*)(F.lds + F.wave * 4096);
    volatile LAS unsigned* hist = F.MISC + 128; volatile LAS unsigned* base = F.MISC + 160;
    constexpr int WOFF = 32768, WPITCH = 2064;
    for (int c = F.tid; c < 48 * 128; c += NWAVES * 64) { const int wr_ = c >> 7, wc_ = c & 127;
        *(LAS u32x4*)(F.lds + WOFF + wr_ * WPITCH + wc_ * 16) = *(const u32x4*)(RWBp + (size_t)wr_ * D + wc_ * 8); }
    __syncthreads();
    for (int g0 = F.vcu * NWAVES; g0 < ngroups; g0 += F.G * NWAVES) {
        const int g = g0 + F.wave; const bool act = g < ngroups;
        int e0 = 0, e1 = 0; float gt0 = 0.f, gt1 = 0.f, rstd_t = 0.f; unsigned rk0 = 0, rk1 = 0; int tok = 0; bool tv = false;
        if (act) {
            const int r = g * 16 + row; const int rc = r < nrows ? r : nrows - 1;
            const bf16* xp = HBp + (size_t)rc * D + 16 * kq;
            f32x4 acc[3] = {{0.f, 0.f, 0.f, 0.f}, {0.f, 0.f, 0.f, 0.f}, {0.f, 0.f, 0.f, 0.f}};
            float ssq = 0.f;
            u32x4 xw[16][2];
#pragma unroll
            for (int sp = 0; sp < 16; ++sp) { xw[sp][0] = *(const u32x4*)(xp + 64 * sp); xw[sp][1] = *(const u32x4*)(xp + 64 * sp + 8); }
            const LAS unsigned char* wl = F.lds + WOFF + row * WPITCH + 32 * kq;
#pragma unroll
            for (int sp = 0; sp < 16; ++sp) {
                bf16x8 bw[3][2];
#pragma unroll
                for (int nb = 0; nb < 3; ++nb)
#pragma unroll
                    for (int hf = 0; hf < 2; ++hf) bw[nb][hf] = *(const LAS bf16x8*)(wl + nb * 16 * WPITCH + 128 * sp + 16 * hf);
#pragma unroll
                for (int hf = 0; hf < 2; ++hf) {
#pragma unroll
                    for (int q = 0; q < 4; ++q) { const float lo = bflo(xw[sp][hf][q]), hi = bfhi(xw[sp][hf][q]); ssq += lo * lo + hi * hi; }
                    const bf16x8 ah = __builtin_bit_cast(bf16x8, xw[sp][hf]);
#pragma unroll
                    for (int nb = 0; nb < 3; ++nb) acc[nb] = __builtin_amdgcn_mfma_f32_16x16x32_bf16(ah, bw[nb][hf], acc[nb], 0, 0, 0);
                }
            }
            ssq += __shfl_xor(ssq, 16); ssq += __shfl_xor(ssq, 32);
            const float rstd = 1.0f / sqrtf(ssq * (1.0f / D) + EPS);
            if (kq == 0 && r < nrows) rstd_out[r] = rstd;
            rstd_t = rstd;
#pragma unroll
            for (int nb = 0; nb < 3; ++nb)
#pragma unroll
                for (int i = 0; i < 4; ++i) L[(4 * kq + i) * 52 + 16 * nb + row] = acc[nb][i];
            LDS_WAIT();
            tok = g * 16 + lane; tv = (lane < 16) && (tok < nrows);
            if (tv) {
                const LAS float* lt = L + lane * 52;
                float gl[4]; float gmax = -INFINITY; int grp = 0;
#pragma unroll
                for (int q = 0; q < 4; ++q) { gl[q] = lt[q] * rstd + bg[q]; if (gl[q] > gmax) { gmax = gl[q]; grp = q; } }
                float gs = 0.f;
#pragma unroll
                for (int q = 0; q < 4; ++q) gs += expf(gl[q] - gmax);
                const float pgrp = 1.0f / gs;
                float v0 = -INFINITY, v1 = -INFINITY; int i0 = 0, i1 = 0;
#pragma unroll
                for (int j = 0; j < 8; ++j) { const float v = lt[4 + 8 * grp + j] * rstd + be[8 * grp + j];
                    if (v > v0) { v1 = v0; i1 = i0; v0 = v; i0 = j; } else if (v > v1) { v1 = v; i1 = j; } }
                const float ex = expf(v1 - v0); gt0 = pgrp / (1.0f + ex); gt1 = pgrp * ex / (1.0f + ex);
                e0 = grp * 8 + i0; e1 = grp * 8 + i1;
                rk0 = __hip_atomic_fetch_add((LAS unsigned*)(hist + e0), 1u, __ATOMIC_RELAXED, __HIP_MEMORY_SCOPE_WORKGROUP);
                rk1 = __hip_atomic_fetch_add((LAS unsigned*)(hist + e1), 1u, __ATOMIC_RELAXED, __HIP_MEMORY_SCOPE_WORKGROUP);
            }
        }
        __syncthreads();
        if (F.tid < 32) { const unsigned c = hist[F.tid]; if (c) base[F.tid] = atomicAdd(cnt + F.tid, c); }
        __syncthreads();
        if (tv) {
            const unsigned p0 = base[e0] + rk0, p1 = base[e1] + rk1;
            list[(size_t)e0 * CAP + p0] = (unsigned)tok * 2u;      gatep[(size_t)e0 * CAP + p0] = ((unsigned)tok * 2u)      | ((unsigned)(gt0 * 32767.0f + 0.5f) << 17); rstdp[(size_t)e0 * CAP + p0] = rstd_t;
            list[(size_t)e1 * CAP + p1] = (unsigned)tok * 2u + 1u; gatep[(size_t)e1 * CAP + p1] = ((unsigned)tok * 2u + 1u) | ((unsigned)(gt1 * 32767.0f + 0.5f) << 17); rstdp[(size_t)e1 * CAP + p1] = rstd_t;
        }
        __syncthreads();
        if (F.tid < 32) hist[F.tid] = 0u;
        __syncthreads();
    }
}
DI void moe_tables(Frame& F, const unsigned* cnt) {
    volatile LAS int* pre = (volatile LAS int*)(F.MISC + 16); volatile LAS int* lc = (volatile LAS int*)(F.MISC + 64);
    __syncthreads();
    if (F.tid == 0) { int acc = 0; for (int e = 0; e < 32; ++e) { const int n = (int)__hip_atomic_load(cnt + e, __ATOMIC_RELAXED, __HIP_MEMORY_SCOPE_AGENT); lc[e] = n; pre[e] = acc; acc += (n + 255) >> 8; } pre[32] = acc; }
    __syncthreads();
}

struct Args { const float* in[22]; float* out; unsigned char* ws; int ph_lo, ph_hi, use_bar, pad; };
constexpr int NPHASE = 15;


typedef const Args __attribute__((address_space(4)))* KArgsP;
DI KArgsP kargs_ptr() { auto p = __builtin_amdgcn_kernarg_segment_ptr(); asm volatile("" : "+s"(p)); return (KArgsP)p; }
#define KARGS() KArgsP AP = kargs_ptr()
__global__ void __launch_bounds__(NWAVES * 64, 2) mk_fwd(Args args) {
    extern __shared__ __attribute__((aligned(16))) unsigned char lds_raw[];
    Frame F;
    F.lds = (LAS unsigned char*)lds_raw; F.MISC = (volatile LAS unsigned*)(F.lds + MISC_OFF);
    F.tid = threadIdx.x; F.lane = F.tid & 63; F.wave = __builtin_amdgcn_readfirstlane(F.tid >> 6);
    F.G = gridDim.x; { const int bx = blockIdx.x; F.vcu = (F.G % 8 == 0) ? (bx % 8) * (F.G / 8) + bx / 8 : bx; }
    F.ws = args.ws; F.ctl = (unsigned*)(args.ws + WS_CTL);
    for (int u = F.tid; u < (LDS_BYTES - MISC_OFF) / 4; u += NWAVES * 64) F.MISC[u] = 0u;
    __syncthreads();
    XcdBarrier bar; bar.bar = F.ctl + CW_BAR; bar.x = 0; bar.st = nullptr;
    if (args.use_bar) bar = xcd_barrier_post(F.ctl + CW_BAR, F.MISC);
#define GRID_BAR() do { xcd_barrier(bar); } while (0)
    const int lo = args.ph_lo, hi = args.ph_hi;
#ifdef PH_ONLY
#define IN(k) ((k) == PH_ONLY)
#else
#define IN(k) (lo <= (k) && (k) < hi)
#endif
#define SEAM(k) do { if (IN(k) && IN((k) + 1)) GRID_BAR(); F_REFRESH(); } while (0)
#define F_REFRESH() do { int t_ = threadIdx.x; asm volatile("" : "+v"(t_)); F.tid = t_; F.lane = t_ & 63; } while (0)

#define x_in (AP->in[0])
#define meta_tokens (AP->in[1])
#define a_norm (AP->in[2])
#define a_w_in (AP->in[3])
#define a_conv (AP->in[4])
#define a_w_out (AP->in[5])
#define kv_norm (AP->in[6])
#define w_kv (AP->in[7])
#define b_norm (AP->in[8])
#define b_w_q (AP->in[9])
#define b_lambda (AP->in[10])
#define b_subln (AP->in[11])
#define b_w_out (AP->in[12])
#define ffn_norm (AP->in[13])
#define r_group (AP->in[14])
#define r_group_b (AP->in[15])
#define r_expert (AP->in[16])
#define r_expert_b (AP->in[17])
#define e_gate (AP->in[18])
#define e_up (AP->in[19])
#define e_down (AP->in[20])
#define final_norm (AP->in[21])
#define out (AP->out)
#define ws (AP->ws)
#define RWB ((bf16*)(ws + WS_RW))
#define ROPE ((float*)(ws + WS_ROPE))
#define RSTDP ((float*)(ws + WS_RSTDP))
#define GATEP ((unsigned*)(ws + WS_GATEP))
#define LIST ((unsigned*)(ws + WS_LIST))
#define WIN ((bf16*)(ws + WS_WIN))
#define WOUT ((bf16*)(ws + WS_WOUT))
#define WQKV ((bf16*)(ws + WS_WQKV))
#define WO ((bf16*)(ws + WS_WO))
#define EGU ((bf16*)(ws + WS_EGU))
#define ED ((bf16*)(ws + WS_ED))
#define XN ((bf16*)(ws + WS_XN))
#define HB XN
#define RSTD ((float*)(ws + WS_RSTD))
#define R2 ((bf16*)(ws + WS_R2))
#define R3 ((bf16*)(ws + WS_R3))
#define ACT R2
#define Y ((bf16*)(ws + WS_Y))
#define KB ((bf16*)(ws + WS_K))
#define VB ((bf16*)(ws + WS_V))
#define V8B ((unsigned char*)(ws + WS_V8))
#define K8B ((unsigned char*)(ws + WS_K8))
#define Q8B ((unsigned char*)(ws + WS_R2))
#define CNT0 (F.ctl + CW_CNT)
#define CNT1 (F.ctl + CW_CNT + 32)
#define gw (F.vcu * NWAVES + F.wave)
#define NGW (F.G * NWAVES)
#define gt (gw * 64 + F.lane)
#define NGT (NGW * 64)
#define scr ((LAS float*)(F.lds + F.wave * 16384))

    if (IN(0)) { KARGS();
        { const P0Src P{nullptr, e_up, e_down, ffn_norm, a_w_in, a_norm, a_w_out, b_w_q, b_norm, w_kv, kv_norm, b_w_out, EGU, ED, WIN, WOUT, WQKV, WO}; p0_convert_all(F, P); }
        for (int i = gt; i < 2 * 48 * D; i += NGT) { const int l = i / (48 * D), o = (i / D) % 48, k = i % D;
            float w = 0.f;
            if (o < 36) w = ((o < 4) ? r_group[((size_t)l * D + k) * NGRP + o] : r_expert[((size_t)l * D + k) * NE + (o - 4)]) * ffn_norm[l * D + k];
            RWB[i] = (bf16)(cvtpk(w, 0.f) & 0xffffu); }
        for (int i = gt; i < (SEQ + NMETA + 3) * 8; i += NGT) { const int row = i >> 3, j = i & 7;
            const int pos = row < SEQ + NMETA ? row : (row == SEQ + NMETA ? 16 : (row == SEQ + NMETA + 1 ? 80 : 128));
            const float inv = (float)pow(500000.0, -(double)j / 8.0); const float ang = (float)pos * inv;
            ROPE[row * 16 + j] = (float)cos((double)ang); ROPE[row * 16 + 8 + j] = (float)sin((double)ang); }
        for (int r = gw; r < NV; r += 2 * NGW) { const int r2 = r + NGW; const bool h2 = r2 < NV;
            const Row16 xa = load_row(hrow(x_in, meta_tokens, r), F.lane); Row16 xb = xa; if (h2) xb = load_row(hrow(x_in, meta_tokens, r2), F.lane);
            const float ra = 1.0f / sqrtf(row_sumsq(xa) * (1.0f / D) + EPS), rb = 1.0f / sqrtf(row_sumsq(xb) * (1.0f / D) + EPS);
            store_row_bf16(HB + (size_t)r * D, xa, 1.0f, F.lane); if (h2) store_row_bf16(HB + (size_t)r2 * D, xb, 1.0f, F.lane);
            if (F.lane == 0) { RSTD[r] = ra; if (h2) RSTD[r2] = rb; } }
    }
    SEAM(0);
    if (IN(1)) { KARGS();
        if (gw < 64) {
            const int j = gw, ch0 = 16 * j, crow = 1024 + (ch0 >> 7) * 256 + (ch0 & 127); const bf16* A16 = HB + (size_t)TR * D;
            const f32x4 ab = meta_tile(A16, D, WIN + (size_t)ch0 * D, D, F.lane), ac = meta_tile(A16, D, WIN + (size_t)crow * D, D, F.lane), au = meta_tile(A16, D, WIN + (size_t)(crow + 128) * D, D, F.lane);
#pragma unroll
            for (int i = 0; i < 4; ++i) { const int r = TR + 4 * (F.lane >> 4) + i; const float rs = RSTD[r];
                R2[(size_t)r * D + ch0 + (F.lane & 15)] = f2bf(ab[i] * rs); R3[(size_t)r * D + ch0 + (F.lane & 15)] = f2bf(ac[i] * au[i] * rs * rs); }
        }
        DenseSched S{HB, WIN, D, 12, F.G, (int)blockIdx.x, 0, 0, ExpJob{e_gate, e_up, e_down, ffn_norm, EGU, ED, gw, NGW}}; EpiInProj E{R2, R3, RSTD, {}};
        pg8::gemm_phase<EpiInProj, DenseSched, true>(F.lds, D, S, E);
        { const int nun = (1536 - (int)blockIdx.x + F.G - 1) / F.G, kmax = (32 * 3 * 128 + NGW - 1) / NGW;
          for (int k = nun; k < kmax; ++k) expjob_item(S.job, k, F.lane); }
    }
    SEAM(1);
    if (IN(2)) { KARGS();
        f32x4 cw[3][4];
#pragma unroll
        for (int k = 0; k < 3; ++k)
#pragma unroll
            for (int j = 0; j < 4; ++j) cw[k][j] = *((const f32x4*)(a_conv + k * D) + F.lane + 64 * j);
        for (int g = gw; g < NV / 16; g += NGW) {
            const int r0 = 16 * g;
            int q1, q2; float z = 1.f;
            if (r0 >= TR) { q1 = r0; q2 = r0; z = 0.f; } else if ((r0 & (SEQ - 1)) == 0) { q1 = TR + 15; q2 = TR + 14; } else { q1 = r0 - 1; q2 = r0 - 2; }
            Row8 c1 = load_row8(R3 + (size_t)q1 * D, F.lane), c2 = load_row8(R3 + (size_t)q2 * D, F.lane);
            float z1 = z, z2 = z;
#pragma unroll 4
            for (int i = 0; i < 16; ++i) {
                const int r = r0 + i;
                const Row8 c0 = load_row8(R3 + (size_t)r * D, F.lane), bb = load_row8(R2 + (size_t)r * D, F.lane);
                u32x2 ov[4];
#pragma unroll
                for (int j = 0; j < 4; ++j) { const u32x2 wb = bb.w[j], w0 = c0.w[j], w1 = c1.w[j], w2 = c2.w[j];
                    const float m0 = bflo(wb.x) * (cw[2][j][0] * bflo(w0.x) + z1 * cw[1][j][0] * bflo(w1.x) + z2 * cw[0][j][0] * bflo(w2.x));
                    const float m1 = bfhi(wb.x) * (cw[2][j][1] * bfhi(w0.x) + z1 * cw[1][j][1] * bfhi(w1.x) + z2 * cw[0][j][1] * bfhi(w2.x));
                    const float m2 = bflo(wb.y) * (cw[2][j][2] * bflo(w0.y) + z1 * cw[1][j][2] * bflo(w1.y) + z2 * cw[0][j][2] * bflo(w2.y));
                    const float m3 = bfhi(wb.y) * (cw[2][j][3] * bfhi(w0.y) + z1 * cw[1][j][3] * bfhi(w1.y) + z2 * cw[0][j][3] * bfhi(w2.y));
                    ov[j].x = cvtpk(m0, m1); ov[j].y = cvtpk(m2, m3); }
                u32x2* po = (u32x2*)(R2 + (size_t)r * D) + F.lane;
#pragma unroll
                for (int j = 0; j < 4; ++j) po[64 * j] = ov[j];
                c2 = c1; c1 = c0; z2 = z1; z1 = 1.f;
            }
        }
    }
    SEAM(2);
    if (IN(3)) { KARGS();
        if (gw < 64) {
            const int c0 = 16 * gw; const f32x4 a = meta_tile(R2 + (size_t)TR * D, D, WOUT + (size_t)c0 * D, D, F.lane);
#pragma unroll
            for (int i = 0; i < 4; ++i) { const int rr = 4 * (F.lane >> 4) + i, c = c0 + (F.lane & 15); HB[(size_t)(TR + rr) * D + c] = f2bf(meta_tokens[rr * D + c] + a[i]); }
        }
        DenseSched S{R2, WOUT, D, 4, F.G, (int)blockIdx.x, 0, 0}; EpiResid<false> E{nullptr, nullptr, HB};
        pg8::gemm_phase<EpiResid<false>, DenseSched, true>(F.lds, D, S, E);
    }
    SEAM(3);
    if (IN(4)) { KARGS();
        route_phase(F, HB, NV, RWB, r_group_b, r_expert_b, CNT0, LIST, RSTD, RSTDP, GATEP);
    }
    SEAM(4);
    if (IN(5)) { KARGS();
        moe_tables(F, CNT0);
        MoeSched<true> S{HB, EGU, D, F.G, (int)blockIdx.x, (volatile LAS int*)(F.MISC + 16), (volatile LAS int*)(F.MISC + 64), LIST, F.ctl + CW_SIG, F.MISC, bar.x}; EpiMoeUp E{ACT, LIST, RSTDP, (volatile LAS int*)(F.MISC + 64), {}};
        pg8::gemm_phase<EpiMoeUp, MoeSched<true>, true>(F.lds, D, S, E);
    }
    if (IN(5) && IN(6)) { moe_handoff(F.ctl + CW_SIG, (volatile LAS int*)(F.MISC + 16), F.G, (int)blockIdx.x, F.ctl + CW_BAR); F_REFRESH(); } else SEAM(5);
    if (IN(6)) { KARGS();
        moe_tables(F, CNT0);
        MoeSched<false> S{ACT, ED, DE, F.G, (int)blockIdx.x, (volatile LAS int*)(F.MISC + 16), (volatile LAS int*)(F.MISC + 64), LIST, nullptr, nullptr, 0u};
        EpiMoeDown E{Y, LIST, GATEP, (volatile LAS int*)(F.MISC + 64), {}};
        pg8::gemm_phase<EpiMoeDown, MoeSched<false>, true>(F.lds, DE, S, E);
    }
    SEAM(6);
    if (IN(7)) { KARGS();
        for (int r = gw; r < NV; r += 2 * NGW) { const int r2 = r + NGW; const bool h2 = r2 < NV; const int rr2 = h2 ? r2 : r;
            Row16 xa, xb;
#pragma unroll
            for (int j = 0; j < 4; ++j) { xa.v[j] = (f32x4){0.f, 0.f, 0.f, 0.f}; xb.v[j] = xa.v[j]; }
            const Row8 ha = load_row8(HB + (size_t)r * D, F.lane), hb2 = load_row8(HB + (size_t)rr2 * D, F.lane);
            const Row8 ya0 = load_row8(Y + (size_t)r * D, F.lane), ya1 = load_row8(Y + ((size_t)MP + r) * D, F.lane);
            const Row8 yb0 = load_row8(Y + (size_t)rr2 * D, F.lane), yb1 = load_row8(Y + ((size_t)MP + rr2) * D, F.lane);
            add_row8(xa, ha); add_row8(xa, ya0); add_row8(xa, ya1); add_row8(xb, hb2); add_row8(xb, yb0); add_row8(xb, yb1);
            const float ra = 1.0f / sqrtf(row_sumsq(xa) * (1.0f / D) + EPS), rb = 1.0f / sqrtf(row_sumsq(xb) * (1.0f / D) + EPS);
            store_row_bf16(HB + (size_t)r * D, xa, 1.0f, F.lane); if (h2) store_row_bf16(HB + (size_t)r2 * D, xb, 1.0f, F.lane);
            if (F.lane == 0) { RSTD[r] = ra; if (h2) RSTD[r2] = rb; } }
    }
    SEAM(7);
    if (IN(8)) { KARGS();
        if (gw < 128) {
            const int sec = gw >> 6, c0 = 16 * (gw & 63), n = F.lane & 15, g4 = F.lane >> 4;
            const f32x4 a = meta_tile(HB + (size_t)TR * D, D, WQKV + (size_t)(1024 + 1024 * sec + c0) * D, D, F.lane); f32x4 mv = {0.f, 0.f, 0.f, 0.f};
#pragma unroll
            for (int i = 0; i < 4; ++i) { const int rr = 4 * g4 + i; float v = a[i] * RSTD[TR + rr]; const float p = __shfl_xor(v, 8);
                if (sec == 0 && (c0 & 63) == 0) { const float cs = ROPE[rr * 16 + (n & 7)], sn = ROPE[rr * 16 + 8 + (n & 7)]; v = (n < 8) ? v * cs - p * sn : v * cs + p * sn; }
                mv[i] = v; }
            unsigned char* himg = (sec == 0 ? K8B : V8B) + ((size_t)((TR / 64) * 8 + (c0 >> 7))) * 8192; const unsigned w = pk4_fp8(mv);
            if (sec == 0) {
                const int dh = c0 & 127; unsigned char* kp = himg + (dh >> 6) * 4096 + ((dh >> 4) & 1) * 1024 + ((dh >> 5) & 1) * 512 + n;
#pragma unroll
                for (int i = 0; i < 4; ++i) kp[(4 * g4 + i) * 16] = (unsigned char)(w >> (8 * i));
#pragma unroll
                for (int j = 0; j < 4; ++j) kp[(16 + g4 + 4 * j) * 16] = 0;
#pragma unroll
                for (int j = 0; j < 8; ++j) kp[2048 + (g4 + 4 * j) * 16] = 0;
            } else {
                unsigned char* img = himg + ((c0 & 127) >> 5) * 1024 + (g4 & 1) * 512 + ((c0 & 31) + n) * 16 + 8 * (F.lane >> 5);
                *(u32x2*)img = (u32x2){w, 0u}; *(u32x2*)(img + 4096) = (u32x2){0u, 0u};
            }
        }
        DenseSched S{HB, WQKV, D, 12, F.G, (int)blockIdx.x, 0, 0, ExpJob{e_gate + (size_t)NE * D * DE, e_up + (size_t)NE * D * DE, e_down + (size_t)NE * DE * D, ffn_norm + D, EGU, ED, gw, NGW}}; EpiQKV E{Q8B, K8B, V8B, ROPE, RSTD, {}};
        pg8::gemm_phase<EpiQKV, DenseSched, true>(F.lds, D, S, E);
    }
    SEAM(8);
    if (IN(9)) { KARGS();
        float d0 = 0.f, d1 = 0.f;
        for (int i = 0; i < HD; ++i) { d0 += b_lambda[i] * b_lambda[HD + i]; d1 += b_lambda[2 * HD + i] * b_lambda[3 * HD + i]; }
        const float lam = __uint_as_float(__builtin_amdgcn_readfirstlane(__float_as_uint(expf(d0) - expf(d1) + LAM_INIT)));
#pragma unroll 1
        for (int v = F.vcu; v < 256; v += F.G) {
            const int bh = v >> 3, s = v & 7;
#pragma unroll 1
            for (int i = 0; i < 4; ++i) { const int qb = (i == 0) ? s : (i == 1) ? 15 - s : (i == 2) ? 16 + s : 31 - s;
                att::attn_unit_checked(bh >> 3, bh & 7, qb, Q8B, K8B, V8B, R3, lam, b_subln, (LAS char*)F.lds, F.MISC + 200);
            }
        }
    }
    SEAM(9);
    if (IN(10)) { KARGS();
        DenseSched S{R3, WO, D, 4, F.G, (int)blockIdx.x, 0, 0}; EpiResid<false> E{nullptr, nullptr, HB};
        pg8::gemm_phase<EpiResid<false>, DenseSched, true>(F.lds, D, S, E);
    }
    SEAM(10);
    if (IN(11)) { KARGS();
        route_phase(F, HB, TR, RWB + 48 * D, r_group_b + NGRP, r_expert_b + NE, CNT1, LIST, RSTD, RSTDP, GATEP);
    }
    SEAM(11);
    if (IN(12)) { KARGS();
        moe_tables(F, CNT1);
        MoeSched<true> S{HB, EGU, D, F.G, (int)blockIdx.x, (volatile LAS int*)(F.MISC + 16), (volatile LAS int*)(F.MISC + 64), LIST, F.ctl + CW_SIG + 2048, F.MISC, bar.x}; EpiMoeUp E{ACT, LIST, RSTDP, (volatile LAS int*)(F.MISC + 64), {}};
        pg8::gemm_phase<EpiMoeUp, MoeSched<true>, true>(F.lds, D, S, E);
    }
    if (IN(12) && IN(13)) { moe_handoff(F.ctl + CW_SIG + 2048, (volatile LAS int*)(F.MISC + 16), F.G, (int)blockIdx.x, F.ctl + CW_BAR); F_REFRESH(); } else SEAM(12);
    if (IN(13)) { KARGS();
        moe_tables(F, CNT1);
        MoeSched<false> S{ACT, ED, DE, F.G, (int)blockIdx.x, (volatile LAS int*)(F.MISC + 16), (volatile LAS int*)(F.MISC + 64), LIST, nullptr, nullptr, 0u};
        EpiMoeDown E{Y, LIST, GATEP, (volatile LAS int*)(F.MISC + 64), {}};
        pg8::gemm_phase<EpiMoeDown, MoeSched<false>, true>(F.lds, DE, S, E);
    }
    SEAM(13);
    if (IN(14)) { KARGS();
        f32x4 fg[4];
#pragma unroll
        for (int j = 0; j < 4; ++j) fg[j] = *((const f32x4*)final_norm + F.lane + 64 * j);
        for (int r = gw; r < TR; r += 2 * NGW) { const int r2 = r + NGW;
            Row16 xa, xb;
#pragma unroll
            for (int j = 0; j < 4; ++j) { xa.v[j] = (f32x4){0.f, 0.f, 0.f, 0.f}; xb.v[j] = xa.v[j]; }
            const Row8 ha = load_row8(HB + (size_t)r * D, F.lane), hb2 = load_row8(HB + (size_t)r2 * D, F.lane);
            const Row8 ya0 = load_row8(Y + (size_t)r * D, F.lane), ya1 = load_row8(Y + ((size_t)MP + r) * D, F.lane);
            const Row8 yb0 = load_row8(Y + (size_t)r2 * D, F.lane), yb1 = load_row8(Y + ((size_t)MP + r2) * D, F.lane);
            add_row8(xa, ha); add_row8(xa, ya0); add_row8(xa, ya1); add_row8(xb, hb2); add_row8(xb, yb0); add_row8(xb, yb1);
            const float ra = 1.0f / sqrtf(row_sumsq(xa) * (1.0f / D) + EPS), rb = 1.0f / sqrtf(row_sumsq(xb) * (1.0f / D) + EPS);
            f32x4* qa = (f32x4*)(out + (size_t)r * D) + F.lane; f32x4* qb = (f32x4*)(out + (size_t)r2 * D) + F.lane;
#pragma unroll
            for (int j = 0; j < 4; ++j) { qa[64 * j] = xa.v[j] * ra * fg[j]; qb[64 * j] = xb.v[j] * rb * fg[j]; } }
    }
#undef IN
#undef SEAM
#undef GRID_BAR
#undef gw
#undef NGW
#undef gt
#undef NGT
#undef scr
#undef x_in
#undef meta_tokens
#undef a_norm
#undef a_w_in
#undef a_conv
#undef a_w_out
#undef kv_norm
#undef w_kv
#undef b_norm
#undef b_w_q
#undef b_lambda
#undef b_subln
#undef b_w_out
#undef ffn_norm
#undef r_group
#undef r_group_b
#undef r_expert
#undef r_expert_b
#undef e_gate
#undef e_up
#undef e_down
#undef final_norm
#undef out
#undef ws
#undef RWB
#undef ROPE
#undef RSTDP
#undef GATEP
#undef LIST
#undef WIN
#undef WOUT
#undef WQKV
#undef WO
#undef EGU
#undef ED
#undef XN
#undef HB
#undef RSTD
#undef R2
#undef R3
#undef ACT
#undef Y
#undef KB
#undef VB
#undef V8B
#undef K8B
#undef Q8B
#undef CNT0
#undef CNT1
}

#ifndef MK_SPLIT
#define MK_SPLIT 0
#endif
extern "C" void kernel_launch(void* const* d_in, const int* in_sizes, int n_in, void* d_out, int out_size, void* d_ws, size_t ws_size, hipStream_t stream) {
    static int grid = 0;
    if (grid == 0) {
        if (n_in != 22 || out_size != TR * D || ws_size < WS_END) { fprintf(stderr, "kernel_launch: unexpected sizes (n_in %d out %d ws %zu)\n", n_in, out_size, ws_size); grid = -1; return; }
        int dev = 0, cus = 0, per_cu = 0;
        if (hipGetDevice(&dev) != hipSuccess || hipDeviceGetAttribute(&cus, hipDeviceAttributeMultiprocessorCount, dev) != hipSuccess) { grid = -1; return; }
        if (hipFuncSetAttribute((const void*)mk_fwd, hipFuncAttributeMaxDynamicSharedMemorySize, LDS_BYTES) != hipSuccess) { fprintf(stderr, "kernel_launch: hipFuncSetAttribute failed\n"); grid = -1; return; }
        if (hipOccupancyMaxActiveBlocksPerMultiprocessor(&per_cu, (const void*)mk_fwd, NWAVES * 64, LDS_BYTES) != hipSuccess || per_cu < 1) { fprintf(stderr, "kernel_launch: occupancy query says %d\n", per_cu); }
        (void)hipGetLastError();
        grid = cus;
    }
    if (grid < 0) return;
    (void)hipMemsetAsync((char*)d_ws + WS_CTL, 0, CTL_ZERO_BYTES, stream);
    Args a{};
    for (int i = 0; i < 22; ++i) a.in[i] = (const float*)d_in[i];
    a.out = (float*)d_out; a.ws = (unsigned char*)d_ws; a.pad = 0;
#if MK_SPLIT
    for (int p = 0; p < NPHASE; ++p) { a.ph_lo = p; a.ph_hi = p + 1; a.use_bar = 0;
        hipLaunchKernelGGL(mk_fwd, dim3(grid), dim3(NWAVES * 64), LDS_BYTES, stream, a); }
#else
    a.ph_lo = 0; a.ph_hi = NPHASE; a.use_bar = 1;
    hipLaunchKernelGGL(mk_fwd, dim3(grid), dim3(NWAVES * 64), LDS_BYTES, stream, a);
#endif
}
```

```cpp
#include <hip/hip_runtime.h>
#include <cstdint>
#include <cstdio>

#define DI __device__ __forceinline__
#define LAS __attribute__((address_space(3)))
#define GAS __attribute__((address_space(1)))

typedef unsigned short bf16;
typedef short bf16x8 __attribute__((ext_vector_type(8)));
typedef short s16x4 __attribute__((ext_vector_type(4)));
typedef float f32x4 __attribute__((ext_vector_type(4)));
typedef float f32x2 __attribute__((ext_vector_type(2)));
typedef float f32x16 __attribute__((ext_vector_type(16)));
typedef unsigned u32x4 __attribute__((ext_vector_type(4)));
typedef unsigned u32x2 __attribute__((ext_vector_type(2)));
typedef __bf16 bf16x2_t __attribute__((ext_vector_type(2)));

constexpr int D = 1024, NB = 4, SEQ = 8192, NMETA = 16;
constexpr int TR = NB * SEQ;
constexpr int NV = TR + NMETA;
constexpr int MP = 129 * 256;
constexpr int NH = 8, HD = 64, NE = 32, NGRP = 4, EPG = 8, DE = 512;
constexpr int CAP = NV;
constexpr float EPS = 1e-6f;
constexpr float LAM_INIT = 0.35550906f;
constexpr float QSCALE = 0.125f * 1.4426950408889634f;

constexpr size_t MiB = 1u << 20;
constexpr size_t WS_CTL = 0, CTL_ZERO_BYTES = 64 * 1024;
constexpr size_t WS_RW = 1 * MiB;
constexpr size_t WS_RSTD = 1 * MiB + 384 * 1024;
constexpr size_t WS_ROPE = 1 * MiB + 640 * 1024;
constexpr size_t WS_LIST = 3 * MiB;
constexpr size_t WS_WIN = 8 * MiB, WS_WOUT = 14 * MiB, WS_WQKV = 16 * MiB, WS_WO = 22 * MiB;
constexpr size_t WS_EGU = 24 * MiB;
constexpr size_t WS_ED = 88 * MiB;
constexpr size_t WS_XN = 120 * MiB;
constexpr size_t WS_R2 = 185 * MiB;
constexpr size_t WS_R3 = 250 * MiB;
constexpr size_t WS_Y = 315 * MiB;
constexpr size_t WS_K = WS_Y, WS_V = WS_Y + 65 * MiB;
constexpr size_t WS_RSTDP = 446 * MiB, WS_GATEP = 452 * MiB;
constexpr size_t WS_K8 = WS_K, WS_V8 = WS_V;
constexpr size_t WS_END = 458 * MiB;
static_assert(WS_RW + 2 * 48 * 1024 * 2 <= WS_RSTD && WS_RSTD + MP * 4 <= WS_ROPE && WS_ROPE + 8211 * 16 * 4 <= WS_LIST && WS_LIST + 32ull * CAP * 4 <= WS_WIN, "ws map small");
static_assert(WS_XN + (size_t)MP * D * 2 <= WS_R2 && WS_R2 + (size_t)MP * D * 2 <= WS_R3 && WS_R3 + (size_t)MP * D * 2 <= WS_Y && WS_Y + 2ull * MP * D * 2 <= WS_RSTDP && WS_GATEP + 6 * MiB <= WS_END, "ws map");
constexpr int CW_CNT = 64;
constexpr int CW_BAR = 4096;
constexpr int CW_SIG = 8192;
static_assert((size_t)(CW_SIG + 2 * 2048) * 4 <= CTL_ZERO_BYTES && (size_t)(CW_BAR + 3456) * 4 <= CTL_ZERO_BYTES, "control words (expert counters, barrier words: 3456 of them, hand-off counters) must lie inside the zeroed region");

constexpr int RING_BYTES = 131072;
constexpr int MISC_OFF = 135168;
constexpr int LDS_BYTES = 147456;
constexpr int NWAVES = 8;

DI unsigned cvtpk(float lo, float hi) { f32x2 v = {lo, hi}; bf16x2_t b = __builtin_convertvector(v, bf16x2_t); return __builtin_bit_cast(unsigned, b); }
DI float bf2f(unsigned short h) { return __uint_as_float(((unsigned)h) << 16); }
DI float bflo(unsigned w) { return __uint_as_float(w << 16); }
DI float bfhi(unsigned w) { return __uint_as_float(w & 0xffff0000u); }
DI u32x4 pack8(const f32x4& a, const f32x4& b) { u32x4 w; w.x = cvtpk(a[0], a[1]); w.y = cvtpk(a[2], a[3]); w.z = cvtpk(b[0], b[1]); w.w = cvtpk(b[2], b[3]); return w; }
DI float wave_sum(float v) {
#pragma unroll
    for (int o = 1; o < 64; o <<= 1) v += __shfl_xor(v, o);
    return v;
}
#define LDS_WAIT() asm volatile("s_waitcnt lgkmcnt(0)" ::: "memory")
#define VM_WAIT() asm volatile("s_waitcnt vmcnt(0)" ::: "memory")

#define XB_TMO      128
#define XB_XCNT(j)  (256  + 64 * (j))
#define XB_XSUB(j)  (1280 + 64 * (j))
#define XB_XGEN(j)  (2304 + 64 * (j))
#define XB_TOP      3328
#define XB_TOPGEN   3392
#define XCD_BAR_WORDS 3456
#define XB_SPIN_CAP (1u << 18)
DI unsigned xb_ld(unsigned* p)              { return __hip_atomic_load(p, __ATOMIC_RELAXED, __HIP_MEMORY_SCOPE_AGENT); }
DI unsigned xb_add(unsigned* p, unsigned v) { return __hip_atomic_fetch_add(p, v, __ATOMIC_RELAXED, __HIP_MEMORY_SCOPE_AGENT); }
DI unsigned xb_xcc_id() { return (unsigned)__builtin_amdgcn_s_getreg((3 << 11) | 20) & 0xFu; }
#define XB_SPIN(cond, bar) do { unsigned _sp = 0; while (cond) { __builtin_amdgcn_s_sleep(1); \
    if ((++_sp & 255u) == 0u) { if (xb_ld(&(bar)[XB_TMO])) break; if (_sp > XB_SPIN_CAP) { atomicAdd(&(bar)[XB_TMO], 1u); break; } } } } while (0)
struct XcdBarrier { unsigned* bar; unsigned x; volatile LAS unsigned* st; };
DI XcdBarrier xcd_barrier_post(unsigned* bar, volatile LAS unsigned* st) {
    XcdBarrier b; b.bar = bar; b.x = xb_xcc_id(); b.st = st;
    if (threadIdx.x == 0) (void)xb_add(&bar[XB_XCNT(b.x)], 1u);
    return b;
}
DI void xcd_barrier_complete(unsigned* bar, unsigned x, unsigned& nloc, unsigned& nx) {
    const unsigned G = gridDim.x * gridDim.y * gridDim.z;
    unsigned sum, cnt, mine, sp = 0u;
    for (;;) {
        sum = 0u; cnt = 0u; mine = 0u;
#pragma unroll
        for (unsigned j = 0; j < 16; ++j) { const unsigned c = xb_ld(&bar[XB_XCNT(j)]); sum += c; cnt += (c > 0u) ? 1u : 0u; mine = (j == x) ? c : mine; }
        if (sum == G) break;
        __builtin_amdgcn_s_sleep(1);
        if ((++sp & 255u) == 0u) { if (xb_ld(&bar[XB_TMO])) break; if (sp > XB_SPIN_CAP) { atomicAdd(&bar[XB_TMO], 1u); break; } }
    }
    nloc = mine > 0u ? mine : 1u; nx = cnt > 0u ? cnt : 1u;
}
DI void xcd_barrier(const XcdBarrier& b) {
    asm volatile("s_waitcnt vmcnt(0)" ::: "memory");
    __syncthreads();
    if (threadIdx.x == 0) {
        unsigned* bar = b.bar;
        __builtin_amdgcn_s_waitcnt(0);
        unsigned nloc = b.st[0], nx = b.st[1];
        if (nloc == 0u) { xcd_barrier_complete(bar, b.x, nloc, nx); b.st[0] = nloc; b.st[1] = nx; }
        const unsigned old = xb_add(&bar[XB_XSUB(b.x)], 1u);
        const unsigned gen = old / nloc;
        if (old + 1u == (gen + 1u) * nloc) {
            __builtin_amdgcn_fence(__ATOMIC_RELEASE, "agent");
            asm volatile("s_waitcnt vmcnt(0)" ::: "memory");
            const unsigned og = xb_add(&bar[XB_TOP], 1u);
            const unsigned tg = og / nx;
            if (og + 1u == (tg + 1u) * nx) {
#pragma unroll
                for (unsigned j = 0; j < 16; ++j) (void)xb_add(&bar[XB_XGEN(j)], 1u);
            } else XB_SPIN(xb_ld(&bar[XB_XGEN(b.x)]) == gen, bar);
            __builtin_amdgcn_fence(__ATOMIC_ACQUIRE, "agent");
            asm volatile("s_waitcnt vmcnt(0)" ::: "memory");
        } else {
            XB_SPIN(xb_ld(&bar[XB_XGEN(b.x)]) == gen, bar);
            __builtin_amdgcn_fence(__ATOMIC_ACQUIRE, "agent");
            asm volatile("s_waitcnt vmcnt(0)" ::: "memory");
        }
    }
    __syncthreads();
}

namespace pg8 {
constexpr int BM = 256, BK = 64, HALF = 128, HTB = HALF * BK * 2, STAGE_BYTES = 8 * HTB, NXCD = 8, WGM = 8;
DI int lds_byte(int r, int c) { const int st = (r >> 4) * 2 + (c >> 5), rr = r & 15, cc = c & 31, ob = rr * 64 + cc * 2; return st * 1024 + (ob ^ (((ob >> 9) & 1) << 5)); }
DI void stage_rc(int b, int& R, int& C) { const int st = b / 1024, sb = b % 1024, swz = sb ^ (((sb >> 9) & 1) << 5); R = (st >> 1) * 16 + swz / 64; C = (st & 1) * 32 + (swz % 64) / 2; }
DI int perm32(int rho) { const int n = rho >> 4, i = rho & 15; return 8 * (i >> 2) + 4 * n + (i & 3); }
struct Unit { int pm, pn, e, rb; };

template <class Epi, class Sched, bool ALIGN_EPI>
DI void gemm_phase(LAS unsigned char* lds, const int K, const Sched S, const Epi E) {
    const int tid = threadIdx.x, wid = __builtin_amdgcn_readfirstlane(tid >> 6), lane = tid & 63, wr = wid >> 2, wc = wid & 3, fr = lane & 15, fq = lane >> 4;
    const int nt = K / BK;
    int RA[2], CA[2]; unsigned voffB[2];
#pragma unroll
    for (int i = 0; i < 2; ++i) { int R, C; stage_rc(tid * 16 + i * 8192, R, C); const int Rb = (R & ~31) + perm32(R & 31);
        RA[i] = R; CA[i] = C; voffB[i] = (unsigned)(Rb * K + C) * 2u; }
    const size_t kstep = (size_t)(BK * 2);
    const size_t hstepB = (size_t)HALF * K * 2;
    const unsigned ldsw = (unsigned)wid * 1024u;
    const int aoff = lds_byte(wr * 64 + fr, fq * 8), boff = lds_byte(wc * 32 + fr, fq * 8);
    const char* const Abase = (const char*)S.A;
#define PG8_SA(b, h) (((b) * 2 + (h)) * HTB)
#define PG8_SB(b, h) ((4 + (b) * 2 + (h)) * HTB)
#define PG8_STAGE_B(bufoff, gbase) do { _Pragma("unroll") for (int _i = 0; _i < 2; ++_i) \
        __builtin_amdgcn_global_load_lds((const unsigned*)((const char*)(gbase) + voffB[_i]), (LAS unsigned*)(lds + (bufoff) + ldsw + _i * 8192), 16, 0, 0); } while (0)
#define PG8_STAGE_A(bufoff, kb, offs) do { _Pragma("unroll") for (int _i = 0; _i < 2; ++_i) \
        __builtin_amdgcn_global_load_lds((const unsigned*)(Abase + (size_t)(offs)[_i] + (size_t)(kb)), (LAS unsigned*)(lds + (bufoff) + ldsw + _i * 8192), 16, 0, 0); } while (0)
#define PG8_LDA(dst, b, h) do { _Pragma("unroll") for (int m = 0; m < 4; ++m) _Pragma("unroll") for (int k = 0; k < 2; ++k) dst[m][k] = *(const LAS bf16x8*)(lds + PG8_SA(b, h) + aoff + m * 2048 + k * 1024); } while (0)
#define PG8_LDB(dst, b, h) do { _Pragma("unroll") for (int n = 0; n < 2; ++n) _Pragma("unroll") for (int k = 0; k < 2; ++k) dst[n][k] = *(const LAS bf16x8*)(lds + PG8_SB(b, h) + boff + n * 2048 + k * 1024); } while (0)
#define PG8_MMA(ai, bj, At, Bt) do { __builtin_amdgcn_s_setprio(1); _Pragma("unroll") for (int m = 0; m < 4; ++m) _Pragma("unroll") for (int n = 0; n < 2; ++n) _Pragma("unroll") for (int k = 0; k < 2; ++k) \
        acc[ai][bj][m][n] = __builtin_amdgcn_mfma_f32_16x16x32_bf16(Bt[n][k], At[m][k], acc[ai][bj][m][n], 0, 0, 0); __builtin_amdgcn_s_setprio(0); } while (0)
#define PG8_WAIT_V(n) asm volatile("s_waitcnt vmcnt(" #n ")" ::: "memory")
#define PG8_WAIT_L(n) asm volatile("s_waitcnt lgkmcnt(" #n ")" ::: "memory")
#define PG8_BAR __builtin_amdgcn_s_barrier()
#define PG8_SCHED __builtin_amdgcn_sched_barrier(0)
    Unit cur, nxt; int ui = 0;
    if (!S.next(0, cur)) return;
    f32x4 acc[2][2][4][2];
#pragma unroll
    for (int a = 0; a < 2; ++a)
#pragma unroll
        for (int b = 0; b < 2; ++b)
#pragma unroll
            for (int m = 0; m < 4; ++m)
#pragma unroll
                for (int n = 0; n < 2; ++n) acc[a][b][m][n] = (f32x4){0.f, 0.f, 0.f, 0.f};
    bf16x8 At[4][2], B0[2][2], B1[2][2];
    unsigned ao_c[2][2], ao_n[2][2];
    S.a_rows(cur, RA, CA, ao_c);
#pragma unroll
    for (int h = 0; h < 2; ++h)
#pragma unroll
        for (int i = 0; i < 2; ++i) asm volatile("" : "+v"(ao_c[h][i]));
    const char* cB = S.b_base(cur);
    E.pre(cur, wr, fr);
    PG8_STAGE_B(PG8_SB(0, 0), cB); PG8_STAGE_B(PG8_SB(0, 1), cB + hstepB); PG8_STAGE_A(PG8_SA(0, 0), 0, ao_c[0]); PG8_STAGE_A(PG8_SA(0, 1), 0, ao_c[1]);
    if (wr == 1) PG8_BAR;
    PG8_WAIT_V(2); PG8_BAR;
    PG8_STAGE_B(PG8_SB(1, 0), cB + kstep); PG8_STAGE_A(PG8_SA(1, 0), kstep, ao_c[0]); PG8_STAGE_B(PG8_SB(1, 1), cB + hstepB + kstep);
    PG8_WAIT_V(6); PG8_BAR;
    for (;;) {
        const bool has_next = S.next(ui + 1, nxt);
        const char* nB = cB;
        if (has_next) { S.a_rows(nxt, RA, CA, ao_n); nB = S.b_base(nxt); }
        else {
#pragma unroll
            for (int h = 0; h < 2; ++h)
#pragma unroll
                for (int i = 0; i < 2; ++i) ao_n[h][i] = ao_c[h][i];
        }
#pragma unroll
        for (int h = 0; h < 2; ++h)
#pragma unroll
            for (int i = 0; i < 2; ++i) asm volatile("" : "+v"(ao_n[h][i]));
        for (int t = 0; t < nt; t += 2) {
            const bool last = (t == nt - 2);
            const size_t k1 = (size_t)(t + 1) * kstep;
            const size_t k2 = last ? 0 : (size_t)(t + 2) * kstep, k3 = k2 + kstep;
            unsigned a2o[2][2];
#pragma unroll
            for (int h = 0; h < 2; ++h)
#pragma unroll
                for (int i = 0; i < 2; ++i) a2o[h][i] = last ? ao_n[h][i] : ao_c[h][i];
            const char* b2 = last ? nB : cB + (size_t)(t + 2) * kstep; const char* b3 = b2 + kstep;
            PG8_LDB(B0, 0, 0); PG8_LDB(B1, 0, 1); PG8_SCHED; PG8_LDA(At, 0, 0); PG8_STAGE_A(PG8_SA(1, 1), k1, ao_c[1]);
            PG8_WAIT_V(8); PG8_WAIT_L(0); PG8_BAR; PG8_MMA(0, 0, At, B0); PG8_MMA(0, 1, At, B1); PG8_BAR; PG8_SCHED;
            PG8_LDA(At, 0, 1); PG8_STAGE_B(PG8_SB(0, 0), b2); PG8_STAGE_B(PG8_SB(0, 1), b2 + hstepB); PG8_STAGE_A(PG8_SA(0, 0), k2, a2o[0]);
            PG8_WAIT_V(8); PG8_WAIT_L(0); PG8_BAR; PG8_MMA(1, 0, At, B0); PG8_MMA(1, 1, At, B1); PG8_BAR; PG8_SCHED;
            PG8_LDB(B0, 1, 0); PG8_LDB(B1, 1, 1); PG8_SCHED; PG8_LDA(At, 1, 0); PG8_STAGE_A(PG8_SA(0, 1), k2, a2o[1]);
            PG8_WAIT_V(8); PG8_WAIT_L(0); PG8_BAR; PG8_MMA(0, 0, At, B0); PG8_MMA(0, 1, At, B1); PG8_BAR; PG8_SCHED;
            PG8_LDA(At, 1, 1); PG8_STAGE_B(PG8_SB(1, 0), b3); PG8_STAGE_B(PG8_SB(1, 1), b3 + hstepB); PG8_STAGE_A(PG8_SA(1, 0), k3, a2o[0]);
            PG8_WAIT_V(8); PG8_WAIT_L(0); PG8_BAR; PG8_MMA(1, 0, At, B0); PG8_MMA(1, 1, At, B1); PG8_BAR; PG8_SCHED;
        }
        if constexpr (ALIGN_EPI) { if (wr == 0) PG8_BAR; }
        E(acc, cur, wr, wc, fr, fq);
        S.after_unit(ui);
        if (!has_next) break;
#pragma unroll
        for (int a = 0; a < 2; ++a)
#pragma unroll
            for (int b = 0; b < 2; ++b)
#pragma unroll
                for (int m = 0; m < 4; ++m)
#pragma unroll
                    for (int n = 0; n < 2; ++n) acc[a][b][m][n] = (f32x4){0.f, 0.f, 0.f, 0.f};
        cur = nxt; cB = nB; ++ui;
        E.pre(cur, wr, fr);
#pragma unroll
        for (int h = 0; h < 2; ++h)
#pragma unroll
            for (int i = 0; i < 2; ++i) ao_c[h][i] = ao_n[h][i];
        if constexpr (ALIGN_EPI) { if (wr == 1) PG8_BAR; }
    }
    PG8_WAIT_V(0);
    if constexpr (!ALIGN_EPI) { if (wr == 0) PG8_BAR; }
    PG8_BAR;
#undef PG8_SA
#undef PG8_SB
#undef PG8_STAGE_A
#undef PG8_STAGE_B
#undef PG8_LDA
#undef PG8_LDB
#undef PG8_MMA
#undef PG8_WAIT_V
#undef PG8_WAIT_L
#undef PG8_BAR
#undef PG8_SCHED
}
}
using pg8::Unit;

struct ExpJob { const float *eg, *eu, *ed, *gain; bf16 *EGUp, *EDp; int gw, ngw; };
DI void expjob_item(const ExpJob& J, int k, int lane);
struct DenseSched {
    const void* A; const bf16* Bt; int K, nN, G, c, metaN0, metaNN; ExpJob job;
    DI void after_unit(int ui) const { if (job.eg) expjob_item(job, ui, threadIdx.x & 63); }
    DI bool next(int i, Unit& u) const {
        const int nM = 128, nwg = nM * nN; const int L = i * G + c;
        if (L >= nwg + metaNN) return false;
        u.e = 0; u.rb = 0;
        if (L >= nwg) { u.pm = 128; u.pn = metaN0 + (L - nwg); return true; }
        int wgid = L; { const int q = nwg / 8, r = nwg % 8, xcd = wgid % 8, off = wgid / 8; wgid = (xcd < r ? xcd * (q + 1) : r * (q + 1) + (xcd - r) * q) + off; }
        const int nig = 8 * nN, gid = wgid / nig, fm = gid * 8, gsz = (nM - fm) < 8 ? (nM - fm) : 8;
        u.pm = fm + ((wgid % nig) % gsz); u.pn = (wgid % nig) / gsz; return true;
    }
    DI void a_rows(const Unit& u, const int (&RA)[2], const int (&CA)[2], unsigned (&ao)[2][2]) const {
#pragma unroll
        for (int h = 0; h < 2; ++h)
#pragma unroll
            for (int i = 0; i < 2; ++i) ao[h][i] = (unsigned)((u.pm * 256 + h * 128 + RA[i]) * K + CA[i]) * 2u;
    }
    DI const char* b_base(const Unit& u) const { return (const char*)Bt + (size_t)u.pn * 256 * K * 2; }
};
template <bool GATHER>
struct MoeSched {
    const void* A; const bf16* Bt; int K, G, c; const volatile LAS int* pre; const volatile LAS int* cnt; const unsigned* list; unsigned* sig; const volatile LAS unsigned* xst; unsigned xid;
    DI bool decode(int L, Unit& u) const {
        const int blk = L >> 2; int e = 0;
        for (int j = 1; j < 32; ++j) e += (pre[j] <= blk) ? 1 : 0;
        u.e = e; u.rb = blk - pre[e]; u.pm = blk; u.pn = e * 4 + (L & 3); return true;
    }
    DI bool next(int i, Unit& u) const {
        const int U = pre[32] * 4; int L = i * G + c;
        if (!GATHER) {
            const int Rf = U / G, rem = U - Rf * G, Ne = Rf * G, F = (U + 2 * rem + G - 1) / G, nl = F - 2;
            if (nl >= 1) {
                if (c < rem) { if (i >= nl) return false; L = (i == 0) ? Ne + c : Ne - 1 - ((i - 1) * rem + c); }
                else { L = i * (G - rem) + (c - rem); if (i >= F || L >= Ne - rem * (nl - 1)) return false; }
                return decode(L, u);
            }
        }
        if (L >= U) return false;
        return decode(L, u);
    }
    DI void a_rows(const Unit& u, const int (&RA)[2], const int (&CA)[2], unsigned (&ao)[2][2]) const {
        if (GATHER) {
            const int n = cnt[u.e];
#pragma unroll
            for (int h = 0; h < 2; ++h)
#pragma unroll
                for (int i = 0; i < 2; ++i) { int pos = u.rb * 256 + h * 128 + RA[i]; pos = pos < n ? pos : 0;
                    const unsigned tokk = list[(size_t)u.e * CAP + pos]; ao[h][i] = (unsigned)((int)(tokk >> 1) * K + CA[i]) * 2u; }
        } else {
#pragma unroll
            for (int h = 0; h < 2; ++h)
#pragma unroll
                for (int i = 0; i < 2; ++i) ao[h][i] = (unsigned)((u.pm * 256 + h * 128 + RA[i]) * K + CA[i]) * 2u;
        }
    }
    DI void after_unit(int ui) const {
        if (GATHER && sig) { const int Rf = (pre[32] * 4) / G;
            if (ui == Rf - 1 || ui == Rf) {
                asm volatile("s_waitcnt vmcnt(0)" ::: "memory"); __syncthreads();
                if (threadIdx.x == 0) {
                    if (ui == Rf) { __builtin_amdgcn_fence(__ATOMIC_RELEASE, "agent"); asm volatile("s_waitcnt vmcnt(0)" ::: "memory"); xb_add(sig + 32, 1u); }
                    else { const unsigned nloc = xst[0]; const unsigned old = xb_add(sig + 1024 + 64 * xid, 1u);
                        if (old + 1u == nloc) { __builtin_amdgcn_fence(__ATOMIC_RELEASE, "agent"); asm volatile("s_waitcnt vmcnt(0)" ::: "memory"); xb_add(sig, nloc); } }
                }
            } }
    }
    DI const char* b_base(const Unit& u) const { return (const char*)Bt + (size_t)u.pn * 256 * K * 2; }
};
DI void moe_handoff(unsigned* sig, const volatile LAS int* pre, int G, int c, unsigned* bar) {
    const int U = pre[32] * 4, Rf = U / G, rem = U - Rf * G, F = (U + 2 * rem + G - 1) / G;
    if (threadIdx.x == 0) {
        XB_SPIN(xb_ld(sig) < (unsigned)G, bar);
        if (c < rem || F < 3) XB_SPIN(xb_ld(sig + 32) < (unsigned)rem, bar);
        __builtin_amdgcn_fence(__ATOMIC_ACQUIRE, "agent"); asm volatile("s_waitcnt vmcnt(0)" ::: "memory");
    }
    __syncthreads();
}

DI float xrow16(float v, int fq) { auto rr = __builtin_amdgcn_permlane16_swap(__float_as_uint(v), __float_as_uint(v), false, false); return __uint_as_float((fq & 1) ? rr[0] : rr[1]); }
typedef f32x4 Acc[2][2][4][2];
DI void st16(bf16* p, u32x4 v) { *(u32x4*)p = v; }
struct EpiInProj {
    bf16* Bo; bf16* CUo; const float* rstd; mutable float rsv[8];
    DI void pre(const Unit& u, int wr, int fr) const {
#pragma unroll
        for (int q = 0; q < 8; ++q) rsv[q] = rstd[u.pm * 256 + wr * 64 + fr + (q >> 2) * 128 + (q & 3) * 16]; }
    DI void operator()(const Acc& acc, const Unit& u, int wr, int wc, int fr, int fq) const {
        const int row0 = u.pm * 256 + wr * 64 + fr;
        if (u.pn < 4) {
            const int par = fr & 1; const int col0 = u.pn * 256 + wc * 64 + 32 * par + 8 * fq;
#define XCHF(x) __int_as_float(__builtin_amdgcn_mov_dpp(__float_as_int(x), 0xB1, 0xf, 0xf, true))
#pragma unroll
            for (int ai = 0; ai < 2; ++ai)
#pragma unroll
                for (int m = 0; m < 4; ++m) { const int rA = row0 - par + ai * 128 + m * 16; const float rs = rsv[ai * 4 + m]; bf16* opA = Bo + (size_t)rA * D + col0;
                    f32x4 k0, k1, r0, r1;
#pragma unroll
                    for (int q = 0; q < 4; ++q) { const float a0 = acc[ai][0][m][0][q] * rs, a1 = acc[ai][0][m][1][q] * rs, b0 = acc[ai][1][m][0][q] * rs, b1 = acc[ai][1][m][1][q] * rs;
                        k0[q] = par ? b0 : a0; k1[q] = par ? b1 : a1; r0[q] = XCHF(par ? a0 : b0); r1[q] = XCHF(par ? a1 : b1); }
                    st16(opA, pack8(par ? r0 : k0, par ? r1 : k1)); st16(opA + D, pack8(par ? k0 : r0, par ? k1 : r1)); }
#undef XCHF
        } else {
            const int col0 = (u.pn - 4) * 128 + wc * 32 + 8 * fq;
#pragma unroll
            for (int ai = 0; ai < 2; ++ai)
#pragma unroll
                for (int m = 0; m < 4; ++m) { const int r = row0 + ai * 128 + m * 16; const float rs = rsv[ai * 4 + m]; const float rs2 = rs * rs; bf16* rowp = CUo + (size_t)r * D + col0;
                    st16(rowp, pack8(acc[ai][0][m][0] * acc[ai][1][m][0] * rs2, acc[ai][0][m][1] * acc[ai][1][m][1] * rs2)); }
        }
    }
};
template <bool F32RES>
struct EpiResid {
    const float* res_main; const float* res_meta; bf16* hb;
    DI void pre(const Unit&, int, int) const {}
    DI void operator()(const Acc& acc, const Unit& u, int wr, int wc, int fr, int fq) const {
        static_assert(!F32RES, "in-place bf16 residual only");
        const int par = fr & 1; const int row0 = u.pm * 256 + wr * 64 + fr - par; const int col = u.pn * 256 + wc * 64 + 32 * par + 8 * fq;
#define XCHF(x) __int_as_float(__builtin_amdgcn_mov_dpp(__float_as_int(x), 0xB1, 0xf, 0xf, true))
#pragma unroll
        for (int ai = 0; ai < 2; ++ai)
#pragma unroll
            for (int m = 0; m < 4; ++m) {
                const int rA = row0 + ai * 128 + m * 16;
                if (rA >= TR) continue;
                bf16* opA = hb + (size_t)rA * D + col; bf16* opB = opA + D;
                const u32x4 wA = *(const u32x4*)opA, wB = *(const u32x4*)opB;
                f32x4 k0, k1, r0, r1;
#pragma unroll
                for (int q = 0; q < 4; ++q) { const float a0 = acc[ai][0][m][0][q], a1 = acc[ai][0][m][1][q], b0 = acc[ai][1][m][0][q], b1 = acc[ai][1][m][1][q];
                    k0[q] = par ? b0 : a0; k1[q] = par ? b1 : a1; r0[q] = XCHF(par ? a0 : b0); r1[q] = XCHF(par ? a1 : b1); }
                const f32x4 A0 = par ? r0 : k0, A1 = par ? r1 : k1, B0 = par ? k0 : r0, B1 = par ? k1 : r1;
                st16(opA, pack8((f32x4){bflo(wA.x), bfhi(wA.x), bflo(wA.y), bfhi(wA.y)} + A0, (f32x4){bflo(wA.z), bfhi(wA.z), bflo(wA.w), bfhi(wA.w)} + A1));
                st16(opB, pack8((f32x4){bflo(wB.x), bfhi(wB.x), bflo(wB.y), bfhi(wB.y)} + B0, (f32x4){bflo(wB.z), bfhi(wB.z), bflo(wB.w), bfhi(wB.w)} + B1));
            }
#undef XCHF
    }
};
DI float silu_mul(float g, float u) { return g * __builtin_amdgcn_rcpf(1.0f + __builtin_amdgcn_exp2f(-1.4426950408889634f * g)) * u; }
struct EpiMoeUp {
    bf16* act; const unsigned* list; const float* rstd; const volatile LAS int* cnt; mutable float rsv[8];
    DI void pre(const Unit& u, int wr, int fr) const { const int n = cnt[u.e]; const int pos0 = u.rb * 256 + wr * 64 + fr;
#pragma unroll
        for (int q = 0; q < 8; ++q) { int pos = pos0 + (q >> 2) * 128 + (q & 3) * 16; pos = pos < n ? pos : 0; rsv[q] = rstd[(size_t)u.e * CAP + pos]; } }
    DI void operator()(const Acc& acc, const Unit& u, int wr, int wc, int fr, int fq) const {
        const int row0 = u.pm * 256 + wr * 64 + fr; const int col0 = (u.pn & 3) * 128 + wc * 32 + 8 * fq;
        const int n = cnt[u.e]; const int pos0 = u.rb * 256 + wr * 64 + fr;
#pragma unroll
        for (int ai = 0; ai < 2; ++ai)
#pragma unroll
            for (int m = 0; m < 4; ++m) {
                const float rs = rsv[ai * 4 + m];
                f32x4 a0, a1;
                const float c1 = -1.4426950408889634f * rs, rs2 = rs * rs;
#pragma unroll
                for (int j = 0; j < 4; ++j) { const float g0 = acc[ai][0][m][0][j], g1 = acc[ai][0][m][1][j];
                    a0[j] = (g0 * acc[ai][1][m][0][j]) * (rs2 * __builtin_amdgcn_rcpf(1.0f + __builtin_amdgcn_exp2f(c1 * g0)));
                    a1[j] = (g1 * acc[ai][1][m][1][j]) * (rs2 * __builtin_amdgcn_rcpf(1.0f + __builtin_amdgcn_exp2f(c1 * g1))); }
                st16(act + (size_t)(row0 + ai * 128 + m * 16) * DE + col0, pack8(a0, a1));
            }
    }
};
struct EpiMoeDown {
    bf16* Y; const unsigned* list; const unsigned* gate; const volatile LAS int* cnt; mutable unsigned tkv[8];
    DI void finish() const {}
    DI void pre(const Unit& u, int wr, int fr) const { const int n = cnt[u.e]; const int pos0 = u.rb * 256 + wr * 64 + fr;
#pragma unroll
        for (int q = 0; q < 8; ++q) { int pos = pos0 + (q >> 2) * 128 + (q & 3) * 16; pos = pos < n ? pos : 0; tkv[q] = gate[(size_t)u.e * CAP + pos]; } }
    DI void operator()(const Acc& acc, const Unit& u, int wr, int wc, int fr, int fq) const {
        const int n = cnt[u.e]; const int pos0 = u.rb * 256 + wr * 64 + fr; const int par = fr & 1; const int col0 = (u.pn & 3) * 256 + wc * 64 + 32 * par + 8 * fq;
#define XCH(x) ((unsigned)__builtin_amdgcn_mov_dpp((int)(x), 0xB1, 0xf, 0xf, true))
#pragma unroll
        for (int ai = 0; ai < 2; ++ai)
#pragma unroll
            for (int m = 0; m < 4; ++m) {
                const int posA = pos0 + ai * 128 + m * 16 - par;
                const unsigned tw = tkv[ai * 4 + m], tp = XCH(tw); const unsigned twA = par ? tp : tw, twB = par ? tw : tp;
                const float g = (float)(tw >> 17) * (1.0f / 32767.0f);
                const u32x4 p0 = pack8(acc[ai][0][m][0] * g, acc[ai][0][m][1] * g), p1 = pack8(acc[ai][1][m][0] * g, acc[ai][1][m][1] * g);
                const u32x4 keep = par ? p1 : p0, send = par ? p0 : p1; u32x4 recv;
#pragma unroll
                for (int q = 0; q < 4; ++q) recv[q] = XCH(send[q]);
                const unsigned tA = twA & 0x1ffffu, tB = twB & 0x1ffffu;
                if (posA < n) st16(Y + ((size_t)(tA & 1u) * MP + (tA >> 1)) * D + col0, par ? recv : keep);
                if (posA + 1 < n) st16(Y + ((size_t)(tB & 1u) * MP + (tB >> 1)) * D + col0, par ? keep : recv);
            }
#undef XCH
    }
};
DI unsigned pk4_fp8(const f32x4& v) { int w = __builtin_amdgcn_cvt_pk_fp8_f32(v[0], v[1], 0, false); w = __builtin_amdgcn_cvt_pk_fp8_f32(v[2], v[3], w, true); return (unsigned)w; }
DI unsigned quad_tr(unsigned w, unsigned sel) {
    const unsigned x0 = (unsigned)__builtin_amdgcn_mov_dpp((int)w, 0x00, 0xf, 0xf, true), x1 = (unsigned)__builtin_amdgcn_mov_dpp((int)w, 0x55, 0xf, 0xf, true);
    const unsigned x2 = (unsigned)__builtin_amdgcn_mov_dpp((int)w, 0xaa, 0xf, 0xf, true), x3 = (unsigned)__builtin_amdgcn_mov_dpp((int)w, 0xff, 0xf, 0xf, true);
    return __builtin_amdgcn_perm(x1, x0, sel) | (__builtin_amdgcn_perm(x3, x2, sel) << 16);
}
struct EpiQKV {
    unsigned char* Q8; unsigned char* K8; unsigned char* V8; const float* rope; const float* rstd; mutable float rsv[8];
    DI void pre(const Unit& u, int wr, int fr) const {
#pragma unroll
        for (int q = 0; q < 8; ++q) rsv[q] = rstd[u.pm * 256 + wr * 64 + fr + (q >> 2) * 128 + (q & 3) * 16];
    }
    DI void operator()(const Acc& acc, const Unit& u, int wr, int wc, int fr, int fq) const {
        const int sec = u.pn >> 2;
        const int row0 = u.pm * 256 + wr * 64 + fr; const int colt = (u.pn & 3) * 256 + wc * 32 + 8 * fq;
        const bool rot1 = (sec == 1) && ((wc & 1) == 0), rot0 = rot1 || sec == 0;
        const float sc = sec == 0 ? QSCALE : 1.0f;
        const float sg = (fq == 0) ? -1.0f : 1.0f;
        const float* rp = rope + (size_t)(NMETA + (row0 & (SEQ - 1))) * 16;
        f32x4 cs0 = *(const f32x4*)rp, cs1 = *(const f32x4*)(rp + 4), sn0 = *(const f32x4*)(rp + 8), sn1 = *(const f32x4*)(rp + 12);
        const float* st = rope + (size_t)(SEQ + NMETA) * 16;
        unsigned keep[2][2] = {{0u, 0u}, {0u, 0u}};
        int fr_ = fr, fq_ = fq; asm volatile("" : "+v"(fr_), "+v"(fq_));
        const unsigned sel = (unsigned)(fr_ & 3) * 0x0101u + 0x0c0c0400u;
        unsigned char* const obase = sec == 0 ? Q8 : (sec == 1 ? K8 : V8);
        const unsigned lpart = sec == 0 ? (unsigned)((fr_ & ~1) * D + 32 * (fr_ & 1) + 8 * fq_) : sec == 1 ? (unsigned)((fq_ >> 1) * 1024 + fr_ * 16 + 8 * (fq_ & 1)) : (unsigned)(((fr_ >> 2) & 1) * 512 + (8 * fq_ + (fr_ & 3)) * 16 + 8 * (fr_ >> 3));
#pragma unroll
        for (int ai = 0; ai < 2; ++ai)
#pragma unroll
            for (int m = 0; m < 4; ++m) {
                const int r = row0 + ai * 128 + m * 16; const float rs = rsv[ai * 4 + m];
                if (rot0 && (ai | m) != 0) {
                    const float* sp = st + ((m == 0) ? 16 : 0);
                    const f32x4 dc0 = *(const f32x4*)sp, dc1 = *(const f32x4*)(sp + 4), ds0 = *(const f32x4*)(sp + 8), ds1 = *(const f32x4*)(sp + 12);
                    const f32x4 nc0 = cs0 * dc0 - sn0 * ds0, nc1 = cs1 * dc1 - sn1 * ds1;
                    sn0 = sn0 * dc0 + cs0 * ds0; sn1 = sn1 * dc1 + cs1 * ds1; cs0 = nc0; cs1 = nc1;
                }
#pragma unroll
                for (int bj = 0; bj < 2; ++bj) {
                    f32x4 v0 = acc[ai][bj][m][0] * rs, v1 = acc[ai][bj][m][1] * rs;
                    if (bj == 0 ? rot0 : rot1) {
                        f32x4 p0, p1;
#pragma unroll
                        for (int j = 0; j < 4; ++j) { p0[j] = xrow16(v0[j], fq); p1[j] = xrow16(v1[j], fq); }
                        if (fq < 2) { v0 = v0 * cs0 + p0 * sn0 * sg; v1 = v1 * cs1 + p1 * sn1 * sg; }
                    }
                    v0 = v0 * sc; v1 = v1 * sc;
                    const size_t timg = ((size_t)((u.pm * 4 + ai * 2 + wr) * 8 + (u.pn & 3) * 2 + bj)) * 8192;
                    if (sec == 0) {
                        const u32x2 pc = (u32x2){pk4_fp8(v0), pk4_fp8(v1)};
                        if (bj == 0) { keep[0][0] = pc.x; keep[0][1] = pc.y; }
                        else {
                            const bool par = (fr_ & 1) != 0; const u32x2 q0 = (u32x2){keep[0][0], keep[0][1]}; const u32x2 snd = par ? q0 : pc;
                            u32x2 rcv; rcv.x = (unsigned)__builtin_amdgcn_mov_dpp((int)snd.x, 0xB1, 0xf, 0xf, true); rcv.y = (unsigned)__builtin_amdgcn_mov_dpp((int)snd.y, 0xB1, 0xf, 0xf, true);
                            unsigned char* qa = obase + ((unsigned)((u.pm * 256 + wr * 64 + ai * 128 + m * 16) * D + (u.pn & 3) * 256 + wc * 64) + lpart);
                            *(u32x2*)qa = par ? rcv : q0; *(u32x2*)(qa + D) = par ? pc : rcv;
                        }
                    }
                    else if (sec == 1) *(u32x2*)(obase + (timg + (wc >> 1) * 4096 + (m >> 1) * 2048 + (wc & 1) * 512 + (m & 1) * 256) + lpart) = (u32x2){pk4_fp8(v0), pk4_fp8(v1)};
                    else {
                        const unsigned tlo = quad_tr(pk4_fp8(v0), sel), thi = quad_tr(pk4_fp8(v1), sel);
                        if ((m & 1) == 0) { keep[bj][0] = tlo; keep[bj][1] = thi; }
                        else {
                            unsigned char* img = obase + (timg + (m >> 1) * 4096 + wc * 1024) + lpart;
                            *(u32x2*)img = (u32x2){keep[bj][0], tlo}; *(u32x2*)(img + 64) = (u32x2){keep[bj][1], thi};
                        }
                    }
                }
            }
    }
};

DI f32x4 meta_tile(const bf16* A16, int lda, const bf16* Bt16, int K, int lane) {
    const int r = lane & 15, kq = lane >> 4; f32x4 acc = {0.f, 0.f, 0.f, 0.f};
    const bf16* ap = A16 + (size_t)r * lda + 8 * kq; const bf16* bp = Bt16 + (size_t)r * K + 8 * kq;
#pragma unroll 8
    for (int k0 = 0; k0 < K; k0 += 32) { const bf16x8 a = *(const bf16x8*)(ap + k0), b = *(const bf16x8*)(bp + k0); acc = __builtin_amdgcn_mfma_f32_16x16x32_bf16(a, b, acc, 0, 0, 0); }
    return acc;
}
DI bf16 f2bf(float v) { return (bf16)(cvtpk(v, 0.f) & 0xffffu); }
DI void meta_tile3(const bf16* A16, int lda, const bf16* Bt0, const bf16* Bt1, const bf16* Bt2, int K, int lane, f32x4& o0, f32x4& o1, f32x4& o2) {
    const int r = lane & 15, kq = lane >> 4; f32x4 a0 = {0.f, 0.f, 0.f, 0.f}, a1 = a0, a2 = a0;
    const bf16* ap = A16 + (size_t)r * lda + 8 * kq; const size_t bo = (size_t)r * K + 8 * kq;
#pragma unroll 8
    for (int k0 = 0; k0 < K; k0 += 32) { const bf16x8 a = *(const bf16x8*)(ap + k0), b0 = *(const bf16x8*)(Bt0 + bo + k0), b1 = *(const bf16x8*)(Bt1 + bo + k0), b2 = *(const bf16x8*)(Bt2 + bo + k0);
        a0 = __builtin_amdgcn_mfma_f32_16x16x32_bf16(a, b0, a0, 0, 0, 0); a1 = __builtin_amdgcn_mfma_f32_16x16x32_bf16(a, b1, a1, 0, 0, 0); a2 = __builtin_amdgcn_mfma_f32_16x16x32_bf16(a, b2, a2, 0, 0, 0); }
    o0 = a0; o1 = a1; o2 = a2;
}

namespace att {
constexpr int SLOT = 16384, KOFF = 0, VOFF = 8192, NSLOT = 6, WS_OFF = NSLOT * SLOT, Q1_OFF = WS_OFF + NWAVES * 256, ATT_LDS = Q1_OFF + NWAVES * 4096;
static_assert(ATT_LDS <= MISC_OFF, "attention LDS");
DI int crow(int r, int hi) { return (r & 3) + 8 * (r >> 2) + 4 * hi; }
typedef int v8i32_t __attribute__((ext_vector_type(8)));
DI float xhalf_max(float m) { auto rr = __builtin_amdgcn_permlane32_swap(__float_as_uint(m), __float_as_uint(m), false, false); return __builtin_fmaxf(__uint_as_float(rr[0]), __uint_as_float(rr[1])); }
DI float xhalf_sum(float m) { auto rr = __builtin_amdgcn_permlane32_swap(__float_as_uint(m), __float_as_uint(m), false, false); return __uint_as_float(rr[0]) + __uint_as_float(rr[1]); }
#define MFMA8(a, b, c) __builtin_amdgcn_mfma_scale_f32_32x32x64_f8f6f4((a), (b), (c), 0, 0, 0, 0, 0, 0)
#define ATT_WAIT_BAR(N) asm volatile("s_waitcnt vmcnt(" #N ") lgkmcnt(0)\n\ts_barrier" ::: "memory")
DI void glds16(const void* sbase, unsigned voff, unsigned lds_dst) { unsigned keep;
    asm volatile("s_mov_b32 %0, m0\n\ts_mov_b32 m0, %3\n\ts_nop 0\n\tglobal_load_lds_dwordx4 %1, %2\n\ts_mov_b32 m0, %0" : "=&s"(keep) : "v"(voff), "s"(sbase), "s"(lds_dst) : "memory"); }
template <bool SAFE>
DI bool attn_unit(int b, int h, int qb, const unsigned char* Q8, const unsigned char* K8, const unsigned char* V8, bf16* O, float lam, const float* subg, LAS char* shm) {
    int tid_ = threadIdx.x; asm volatile("" : "+v"(tid_));
    const int tid = tid_, lane = tid & 63, r = lane & 31, hh = lane >> 5; const int wid = __builtin_amdgcn_readfirstlane(tid >> 6);
    const int q0 = qb * 256; const int qrow0 = b * SEQ + q0 + wid * 32;
    const int NT = 4 * qb + 5;
    const int NTw = ((q0 + wid * 32) >> 6) + 2;
    const unsigned lds0 = (unsigned)(uintptr_t)shm;
    LAS float* wsf = (LAS float*)(shm + WS_OFF) + wid * 64;
    const unsigned char* K8h = K8 + (size_t)h * 8192 + (size_t)wid * 1024; const unsigned char* V8h = V8 + (size_t)h * 8192 + (size_t)wid * 1024;
#define ATT_DMA(t, slot) do { const int trow_ = ((t) == 0) ? TR : (b * SEQ + ((t) - 1) * 64); const size_t to_ = (size_t)(trow_ >> 6) * 65536; const unsigned sb_ = lds0 + (unsigned)(slot) + (unsigned)wid * 1024u; \
        glds16(K8h + to_, (unsigned)lane * 16u, (unsigned)__builtin_amdgcn_readfirstlane(sb_ + KOFF)); glds16(V8h + to_, (unsigned)lane * 16u, (unsigned)__builtin_amdgcn_readfirstlane(sb_ + VOFF)); } while (0)
    f32x16 o[2][4];
#pragma unroll
    for (int n = 0; n < 2; ++n)
#pragma unroll
        for (int d = 0; d < 4; ++d)
#pragma unroll
            for (int i = 0; i < 16; ++i) o[n][d][i] = 0.f;
    float mrun[2] = {0.f, 0.f}, lrun[2] = {0.f, 0.f};
    f32x4 ls0 = {0.f, 0.f, 0.f, 0.f}, ls1 = ls0;
    typedef int v4i32_t __attribute__((ext_vector_type(4)));
    const int onew = ((((lane & 15) == 0) && ((lane >> 4) & 1) == 0) || (((lane & 15) == 1) && ((lane >> 4) & 1) == 1)) ? 0x22222222 : 0;
    v4i32_t ones4 = {onew, onew, onew, onew}; asm volatile("" : "+v"(ones4));
    ATT_DMA(0, 0); ATT_DMA(1, SLOT); ATT_DMA(2, 2 * SLOT); ATT_DMA(3, 3 * SLOT); ATT_DMA(4, 4 * SLOT); if (5 < NT) { ATT_DMA(5, 5 * SLOT); }
    const LAS char* q1 = shm + Q1_OFF + wid * 4096 + lane * 16;
    {
        const unsigned qoff = (unsigned)(r * D + hh * 32); const unsigned char* Qw = Q8 + (size_t)qrow0 * D + h * 128;
        const unsigned qdst = lds0 + Q1_OFF + (unsigned)wid * 4096u;
#pragma unroll
        for (int ms = 0; ms < 4; ++ms) glds16(Qw + (ms >> 1) * 64 + (ms & 1) * 16, qoff, (unsigned)__builtin_amdgcn_readfirstlane(qdst + ms * 1024));
    }
    ATT_WAIT_BAR(0);
#define SB() __builtin_amdgcn_sched_barrier(0)
#define RD8(dst, P, PL) do { const u32x4 lo_ = *(const LAS u32x4*)(P), hi_ = *(const LAS u32x4*)((P) + (PL)); dst = (v8i32_t){(int)lo_[0], (int)lo_[1], (int)lo_[2], (int)lo_[3], (int)hi_[0], (int)hi_[1], (int)hi_[2], (int)hi_[3]}; } while (0)
#define ATT_SM8(S, NC, MASKED, PA, O4) do { \
        if ((MASKED) < 32) { asm volatile("; meta-tile mask" ::: "memory"); _Pragma("unroll") for (int i_ = 0; i_ < 16; ++i_) { if (crow(i_, hh) >= (MASKED)) S[i_] = -INFINITY; } } \
        if (SAFE) { \
            float mx_ = __builtin_fmaxf(__builtin_fmaxf(S[0], S[1]), S[2]); \
            _Pragma("unroll") for (int i_ = 3; i_ < 15; i_ += 2) mx_ = __builtin_fmaxf(__builtin_fmaxf(mx_, S[i_]), S[i_ + 1]); \
            mx_ = __builtin_fmaxf(mx_, S[15]); mx_ = xhalf_max(mx_); \
            const bool grow_ = mx_ > mrun[NC] + 8.0f; \
            if (__any(grow_)) { const float mnew_ = grow_ ? mx_ : mrun[NC]; const float f_ = __builtin_amdgcn_exp2f(mrun[NC] - mnew_); mrun[NC] = mnew_; lrun[NC] *= f_; \
                if (hh == 0) wsf[r] = f_; LDS_WAIT(); \
                _Pragma("unroll") for (int g_ = 0; g_ < 4; ++g_) { const f32x4 fv_ = *(const LAS f32x4*)(wsf + 8 * g_ + 4 * hh); \
                    _Pragma("unroll") for (int d_ = 0; d_ < 4; ++d_) _Pragma("unroll") for (int j_ = 0; j_ < 4; ++j_) o[NC][d_][4 * g_ + j_] *= fv_[j_]; } \
                LDS_WAIT(); } \
            const float mm_ = mrun[NC]; \
            _Pragma("unroll") for (int i_ = 0; i_ < 16; ++i_) S[i_] = S[i_] - mm_; \
        } \
        { float ls_ = 0.f; \
          _Pragma("unroll") for (int g_ = 0; g_ < 4; ++g_) { const int i0_ = 4 * (((g_ & 1) << 1) | (g_ >> 1)); \
              const float e0_ = __builtin_amdgcn_exp2f(S[i0_]), e1_ = __builtin_amdgcn_exp2f(S[i0_ + 1]), e2_ = __builtin_amdgcn_exp2f(S[i0_ + 2]), e3_ = __builtin_amdgcn_exp2f(S[i0_ + 3]); \
              ls_ += (e0_ + e1_) + (e2_ + e3_); int w_ = __builtin_amdgcn_cvt_pk_fp8_f32(e0_, e1_, 0, false); w_ = __builtin_amdgcn_cvt_pk_fp8_f32(e2_, e3_, w_, true); PA[(O4) + g_] = w_; \
              if (g_ == 1) SB(); } \
          lrun[NC] += ls_; } \
    } while (0)
#define ATT_QS8(KC, MASKED, O4, VPRE) do { \
        f32x16 S_; v8i32_t ka_, qa_, kb_, qb_; \
        _Pragma("unroll") for (int i_ = 0; i_ < 16; ++i_) S_[i_] = SAFE ? 0.f : -2.0f; \
        RD8(ka_, KC, 1024); RD8(qa_, q1, 1024); SB(); \
        RD8(kb_, (KC) + 4096, 1024); RD8(qb_, q1 + 2048, 1024); SB(); \
        S_ = MFMA8(ka_, qa_, S_); SB(); \
        ATT_SM8(S_, 0, MASKED, pa_, O4); SB(); \
        _Pragma("unroll") for (int i_ = 0; i_ < 16; ++i_) S_[i_] = SAFE ? 0.f : -2.0f; \
        if (VPRE) { RD8(va8_, v8c, 4096); RD8(vb8_, v8c + 1024, 4096); } SB(); \
        S_ = MFMA8(kb_, qb_, S_); SB(); \
        ATT_SM8(S_, 1, MASKED, pb_, O4); SB(); \
    } while (0)
#define ATT_SM8H(S, NC, MASKED, PA, O4, H) do { \
        if ((H) == 0 && (MASKED) < 32) { asm volatile("; meta-tile mask" ::: "memory"); _Pragma("unroll") for (int i_ = 0; i_ < 16; ++i_) { if (crow(i_, hh) >= (MASKED)) S[i_] = -INFINITY; } } \
        { const int ia_ = 4 * (((2 * (H)) & 1) << 1 | ((2 * (H)) >> 1)), ib_ = 4 * ((((2 * (H) + 1) & 1) << 1) | ((2 * (H) + 1) >> 1)); \
          const float e0_ = __builtin_amdgcn_exp2f(S[ia_]), e1_ = __builtin_amdgcn_exp2f(S[ia_ + 1]), e2_ = __builtin_amdgcn_exp2f(S[ia_ + 2]), e3_ = __builtin_amdgcn_exp2f(S[ia_ + 3]); \
          const float f0_ = __builtin_amdgcn_exp2f(S[ib_]), f1_ = __builtin_amdgcn_exp2f(S[ib_ + 1]), f2_ = __builtin_amdgcn_exp2f(S[ib_ + 2]), f3_ = __builtin_amdgcn_exp2f(S[ib_ + 3]); \
          int wa_ = __builtin_amdgcn_cvt_pk_fp8_f32(e0_, e1_, __float_as_int(e0_), false); wa_ = __builtin_amdgcn_cvt_pk_fp8_f32(e2_, e3_, wa_, true); \
          int wb_ = __builtin_amdgcn_cvt_pk_fp8_f32(f0_, f1_, __float_as_int(f0_), false); wb_ = __builtin_amdgcn_cvt_pk_fp8_f32(f2_, f3_, wb_, true); \
          asm volatile("" : "+v"(wa_), "+v"(wb_)); PA[(O4) + 2 * (H)] = wa_; PA[(O4) + 2 * (H) + 1] = wb_; } \
    } while (0)
#define ATT_QKASM(SD, KF, QF) asm volatile("v_mfma_f32_32x32x64_f8f6f4 %0, %1, %2, -2.0" : "=&v"(SD) : "v"(KF), "v"(QF))
#define ATT_QKASM_S(SD, KF, QF, SP) asm volatile("v_mfma_f32_32x32x64_f8f6f4 %0, %2, %3, -2.0" : "=&v"(SD), "+v"(SP) : "v"(KF), "v"(QF))
#define ATT_PVASM(OACC, PP, VF) asm volatile("s_nop 1\n\tv_mfma_f32_32x32x64_f8f6f4 %0, %1, %2, %0" : "+v"(OACC) : "v"(PP), "v"(VF))
#define ATT_PVASM_S(OACC, PP, VF, SD) asm volatile("s_nop 1\n\tv_mfma_f32_32x32x64_f8f6f4 %0, %2, %3, %0" : "+v"(OACC), "+v"(SD) : "v"(PP), "v"(VF))
#define ATT_SUMASM(LACC, PP) asm volatile("v_mfma_f32_16x16x128_f8f6f4 %0, %1, %2, %0 blgp:4" : "+v"(LACC) : "v"(PP), "v"(ones4))
#define ATT_PIECE(S, G, PA, O4) do { const int i0_ = 4 * ((((G) & 1) << 1) | ((G) >> 1)); \
        const float e0_ = __builtin_amdgcn_exp2f(S[i0_]), e1_ = __builtin_amdgcn_exp2f(S[i0_ + 1]), e2_ = __builtin_amdgcn_exp2f(S[i0_ + 2]), e3_ = __builtin_amdgcn_exp2f(S[i0_ + 3]); \
        int w_ = __builtin_amdgcn_cvt_pk_fp8_f32(e0_, e1_, __float_as_int(e0_), false); w_ = __builtin_amdgcn_cvt_pk_fp8_f32(e2_, e3_, w_, true); \
        asm volatile("" : "+v"(w_)); PA[(O4) + (G)] = w_; } while (0)
#define ATT_PBLK(SC, SN, PA, O4, DB, PAP, PBP, KQLOAD, VLOAD, EXTRA) do { \
        ATT_PVASM_S(o[0][DB], PAP, va8_, SC); \
        ATT_PIECE(SC, 0, PA, O4); \
        ATT_QKASM_S(SN, kf_, qf_, SC); KQLOAD; \
        ATT_PIECE(SC, 1, PA, O4); \
        ATT_PVASM_S(o[1][DB], PBP, va8_, SC); VLOAD; \
        ATT_PIECE(SC, 2, PA, O4); \
        EXTRA; \
        ATT_PIECE(SC, 3, PA, O4); \
    } while (0)
#define ATT_DRAIN(VP) do { v8i32_t va8_, vb8_; RD8(va8_, VP, 4096); RD8(vb8_, (VP) + 1024, 4096); SB(); \
        o[0][0] = MFMA8(pa_p, va8_, o[0][0]); o[1][0] = MFMA8(pb_p, va8_, o[1][0]); RD8(va8_, (VP) + 2048, 4096); SB(); \
        o[0][1] = MFMA8(pa_p, vb8_, o[0][1]); o[1][1] = MFMA8(pb_p, vb8_, o[1][1]); RD8(vb8_, (VP) + 3072, 4096); SB(); \
        o[0][2] = MFMA8(pa_p, va8_, o[0][2]); o[1][2] = MFMA8(pb_p, va8_, o[1][2]); \
        o[0][3] = MFMA8(pa_p, vb8_, o[0][3]); o[1][3] = MFMA8(pb_p, vb8_, o[1][3]); SB(); ATT_SUMASM(ls0, pa_p); ATT_SUMASM(ls1, pb_p); } while (0)
    int so_c = 0;
#define SO_PREV(c) (((c) == 0) ? (NSLOT - 1) * SLOT : (c) - SLOT)
#define SO_NEXT(c) (((c) == (NSLOT - 1) * SLOT) ? 0 : (c) + SLOT)
#define ATT_TILE_END(t) do { if ((((t) & 1) == 0) && (t) >= 2 && (t) + 1 < NT) { ATT_WAIT_BAR(0); \
            if ((t) + 4 < NT) { ATT_DMA((t) + 4, SO_PREV(SO_PREV(so_c))); } if ((t) + 5 < NT) { ATT_DMA((t) + 5, SO_PREV(so_c)); } } \
        so_c = SO_NEXT(so_c); } while (0)
    if (SAFE) {
#pragma unroll 1
        for (int t = 0; t < NT; ++t) {
            if (t < NTw) {
                const LAS char* kc = shm + so_c + KOFF + lane * 16; const LAS char* v8c = shm + so_c + VOFF + lane * 16;
                const int kv0 = (t == 0) ? 16 : 32, kv1 = (t == 0) ? 0 : 32;
                v8i32_t pa_, pb_, va8_, vb8_;
                ATT_QS8(kc, kv0, 0, false); ATT_QS8(kc + 2048, kv1, 4, true);
                o[0][0] = MFMA8(pa_, va8_, o[0][0]); o[1][0] = MFMA8(pb_, va8_, o[1][0]); RD8(va8_, v8c + 2048, 4096); SB();
                o[0][1] = MFMA8(pa_, vb8_, o[0][1]); o[1][1] = MFMA8(pb_, vb8_, o[1][1]); RD8(vb8_, v8c + 3072, 4096); SB();
                o[0][2] = MFMA8(pa_, va8_, o[0][2]); o[1][2] = MFMA8(pb_, va8_, o[1][2]);
                o[0][3] = MFMA8(pa_, vb8_, o[0][3]); o[1][3] = MFMA8(pb_, vb8_, o[1][3]); SB();
            }
            ATT_TILE_END(t);
        }
    } else {
        v8i32_t pa_p = {0, 0, 0, 0, 0, 0, 0, 0}, pb_p = {0, 0, 0, 0, 0, 0, 0, 0};
        {
            const LAS char* kc = shm + KOFF + lane * 16; v8i32_t ka_, kb_, qa_, qb_; f32x16 S_;
            RD8(ka_, kc, 1024); RD8(qa_, q1, 1024); RD8(kb_, kc + 4096, 1024); RD8(qb_, q1 + 2048, 1024); SB();
            ATT_QKASM(S_, ka_, qa_); asm volatile("s_nop 15\n\ts_nop 3" : "+v"(S_));
            ATT_SM8H(S_, 0, 16, pa_p, 0, 0); ATT_SM8H(S_, 0, 16, pa_p, 0, 1);
            ATT_QKASM(S_, kb_, qb_); asm volatile("s_nop 15\n\ts_nop 3" : "+v"(S_));
            ATT_SM8H(S_, 1, 16, pb_p, 0, 0); ATT_SM8H(S_, 1, 16, pb_p, 0, 1);
            ATT_TILE_END(0);
        }
        f32x16 S0, S1; v8i32_t kf_, qf_, va8_;
        {   const LAS char* k1 = shm + SLOT + KOFF + lane * 16;
            RD8(kf_, k1, 1024); RD8(qf_, q1, 1024);
            ATT_QKASM(S0, kf_, qf_); asm volatile("s_nop 15\n\ts_nop 3" : "+v"(S0));
            RD8(kf_, k1 + 4096, 1024); RD8(qf_, q1 + 2048, 1024); RD8(va8_, shm + VOFF + lane * 16, 4096); }
#define ATT_TILE(t, PAC, PBC, PAP, PBP) do { \
            const LAS char* v8p = shm + SO_PREV(so_c) + VOFF + lane * 16; const LAS char* kc = shm + so_c + KOFF + lane * 16; const LAS char* kn = shm + SO_NEXT(so_c) + KOFF + lane * 16; \
            ATT_PBLK(S0, S1, PAC, 0, 0, PAP, PBP, RD8(kf_, kc + 2048, 1024); RD8(qf_, q1, 1024), RD8(va8_, v8p + 1024, 4096), ATT_SUMASM(ls0, PAP)); \
            ATT_PBLK(S1, S0, PBC, 0, 1, PAP, PBP, RD8(kf_, kc + 2048 + 4096, 1024); RD8(qf_, q1 + 2048, 1024), RD8(va8_, v8p + 2048, 4096), ATT_SUMASM(ls1, PBP)); \
            ATT_PBLK(S0, S1, PAC, 4, 2, PAP, PBP, RD8(kf_, kn, 1024); RD8(qf_, q1, 1024), RD8(va8_, v8p + 3072, 4096), (void)0); \
            ATT_PBLK(S1, S0, PBC, 4, 3, PAP, PBP, RD8(kf_, kn + 4096, 1024); RD8(qf_, q1 + 2048, 1024), RD8(va8_, shm + so_c + VOFF + lane * 16, 4096), (void)0); \
            ATT_TILE_END(t); } while (0)
        v8i32_t pa_c, pb_c; int t = 1;
        if ((NTw - 1) & 1) { ATT_TILE(t, pa_c, pb_c, pa_p, pb_p); pa_p = pa_c; pb_p = pb_c; t = 2; }
#pragma unroll 1
        for (; t < NTw; t += 2) { ATT_TILE(t, pa_c, pb_c, pa_p, pb_p); ATT_TILE(t + 1, pa_p, pb_p, pa_c, pb_c); }
#undef ATT_TILE
        { const LAS char* v8p = shm + SO_PREV(so_c) + VOFF + lane * 16; ATT_DRAIN(v8p); }
#pragma unroll 1
        for (int t = NTw; t < NT; ++t) ATT_TILE_END(t);
    }
#undef ATT_TILE_END
#undef SO_NEXT
#undef SO_PREV
#undef ATT_DRAIN
#undef ATT_PBLK
#undef ATT_PVASM
#undef ATT_PVASM_S
#undef ATT_PIECE
#undef ATT_SUMASM
#undef ATT_QKASM
#undef ATT_QKASM_S
#undef ATT_SM8H
#undef ATT_QS8
#undef ATT_SM8
#undef RD8
#undef SB
    bool bad = false;
    if (SAFE) { const float l0 = xhalf_sum(lrun[0]), l1 = xhalf_sum(lrun[1]);
        if (hh == 0) { wsf[r] = __builtin_amdgcn_rcpf(l0); wsf[32 + r] = lam * __builtin_amdgcn_rcpf(l1); }
    } else {
        asm volatile("s_nop 15\n\ts_nop 3" : "+v"(ls0), "+v"(ls1));
        const bool own = (lane & 15) < 2; const float thr = 0.1f * (float)(16 + 64 * (NTw - 1));
        const float lmin = __builtin_fminf(__builtin_fminf(__builtin_fminf(ls0[0], ls0[1]), __builtin_fminf(ls0[2], ls0[3])), __builtin_fminf(__builtin_fminf(ls1[0], ls1[1]), __builtin_fminf(ls1[2], ls1[3])));
        bool ok = lmin > thr;
#pragma unroll
        for (int i = 0; i < 4; ++i) ok = ok && (ls0[i] == ls0[i]) && (ls1[i] == ls1[i]);
        bad = __any(own && !ok);
        if (own) { const int qb_ = 16 * (lane & 15) + 4 * (lane >> 4);
#pragma unroll
            for (int i = 0; i < 4; ++i) { wsf[qb_ + i] = __builtin_amdgcn_rcpf(ls0[i]); wsf[32 + qb_ + i] = lam * __builtin_amdgcn_rcpf(ls1[i]); } }
    }
    LDS_WAIT();
    float gsub[4];
#pragma unroll
    for (int d = 0; d < 4; ++d) gsub[d] = subg[32 * d + r];
    int r_o = r; asm volatile("" : "+v"(r_o));
    bf16* Ow = O + (size_t)qrow0 * D + h * 128 + r_o;
#pragma unroll
    for (int g = 0; g < 4; ++g) { const f32x4 c0 = *(const LAS f32x4*)(wsf + 8 * g + 4 * hh), c1 = *(const LAS f32x4*)(wsf + 32 + 8 * g + 4 * hh);
#pragma unroll
        for (int j = 0; j < 4; ++j) { float ssq = 0.f; float y[4];
#pragma unroll
            for (int d = 0; d < 4; ++d) { y[d] = o[0][d][4 * g + j] * c0[j] - o[1][d][4 * g + j] * c1[j]; ssq += y[d] * y[d]; }
#define DPP_ADD(v, ctrl) ((v) + __int_as_float(__builtin_amdgcn_mov_dpp(__float_as_int(v), (ctrl), 0xf, 0xf, true)))
            ssq = DPP_ADD(ssq, 0xB1); ssq = DPP_ADD(ssq, 0x4E); ssq = DPP_ADD(ssq, 0x141); ssq = DPP_ADD(ssq, 0x140);
            ssq += xrow16(ssq, lane >> 4);
#undef DPP_ADD
            const float sc = (1.0f - LAM_INIT) * __builtin_amdgcn_rsqf(ssq * (1.0f / 128.0f) + EPS);
            const int orow = crow(4 * g + j, hh);
#pragma unroll
            for (int d = 0; d < 4; ++d) Ow[(size_t)orow * D + 32 * d] = (bf16)(cvtpk(y[d] * sc * gsub[d], 0.f) & 0xffffu); } }
    asm volatile("s_waitcnt vmcnt(0) lgkmcnt(0)\n\ts_barrier" ::: "memory");
#undef ATT_DMA
    return bad;
}
DI void attn_unit_checked(int b, int h, int qb, const unsigned char* Q8, const unsigned char* K8, const unsigned char* V8, bf16* O, float lam, const float* subg, LAS char* shm, volatile LAS unsigned* flag) {
    const bool bad = attn_unit<false>(b, h, qb, Q8, K8, V8, O, lam, subg, shm);
    if (bad && (threadIdx.x & 63) == 0) flag[0] = 1u;
    asm volatile("s_waitcnt lgkmcnt(0)\n\ts_barrier" ::: "memory");
    const unsigned redo = flag[0];
    asm volatile("s_waitcnt lgkmcnt(0)\n\ts_barrier" ::: "memory");
    if (redo) { if (threadIdx.x == 0) flag[0] = 0u; (void)attn_unit<true>(b, h, qb, Q8, K8, V8, O, lam, subg, shm); }
}
}

struct Frame {
    LAS unsigned char* lds; volatile LAS unsigned* MISC; unsigned* ctl;
    int tid, lane, wave, vcu, G;
    unsigned char* ws;
};
struct TItem { const float* W; bf16* WT; const float* gain; int K, N, k0, n0, drow0, perm; };
DI int perm_row(int c) { return (c & ~255) + 128 * ((c >> 5) & 1) + 32 * ((c >> 6) & 3) + (c & 31); }
DI void titem_load(const TItem& it, f32x4 (&v)[16], int lane) {
    const float* p = it.W + (size_t)(it.k0 + 16 * (lane >> 4)) * it.N + it.n0 + 4 * (lane & 15);
#pragma unroll
    for (int j = 0; j < 16; ++j) v[j] = __builtin_nontemporal_load((const f32x4*)(p + (size_t)j * it.N));
}
DI void titem_store(const TItem& it, f32x4 (&v)[16], int lane_) {
    int lane = lane_; asm volatile("" : "+v"(lane));
    if (it.gain) { const f32x4* g = (const f32x4*)(it.gain + it.k0 + 16 * (lane >> 4));
#pragma unroll
        for (int q = 0; q < 4; ++q) { const f32x4 gv = g[q];
#pragma unroll
            for (int i = 0; i < 4; ++i) v[4 * q + i] = v[4 * q + i] * gv[i]; } }
    const int cl = 4 * (lane & 15); const int drow = it.perm ? it.drow0 + (cl & 31) + ((cl & 32) ? 128 : 0) : it.drow0 + cl;
    const int kq = lane >> 4;
    bf16* o = it.WT + (size_t)drow * it.K + it.k0 + 16 * (kq & 1) + 8 * (kq >> 1);
#pragma unroll
    for (int c = 0; c < 4; ++c) { u32x4 w0, w1;
        w0.x = cvtpk(v[0][c], v[1][c]); w0.y = cvtpk(v[2][c], v[3][c]); w0.z = cvtpk(v[4][c], v[5][c]); w0.w = cvtpk(v[6][c], v[7][c]);
        w1.x = cvtpk(v[8][c], v[9][c]); w1.y = cvtpk(v[10][c], v[11][c]); w1.z = cvtpk(v[12][c], v[13][c]); w1.w = cvtpk(v[14][c], v[15][c]);
#pragma unroll
        for (int q = 0; q < 4; ++q) { auto rr = __builtin_amdgcn_permlane32_swap(w0[q], w1[q], false, false); w0[q] = rr[0]; w1[q] = rr[1]; }
        __builtin_nontemporal_store(w0, (u32x4*)(o + (size_t)c * it.K)); __builtin_nontemporal_store(w1, (u32x4*)(o + (size_t)c * it.K + 32)); }
}
DI TItem expert_item(int it, const float* eg, const float* eu, const float* ed, const float* gain, bf16* EGUp, bf16* EDp) {
    constexpr int IPE = 128;
    const int e = it / (3 * IPE), r = it % (3 * IPE), mat = r / IPE, q = r % IPE; TItem t;
    if (mat < 2) { const int kb = q / 8, nb = q % 8, n0 = nb * 64;
        t.W = (mat == 0 ? eg : eu) + (size_t)e * D * DE; t.WT = EGUp + (size_t)e * 1024 * D; t.gain = gain; t.K = D; t.N = DE; t.k0 = kb * 64; t.n0 = n0; t.drow0 = (n0 >> 7) * 256 + mat * 128 + (n0 & 127); t.perm = 0;
    } else { const int kb = q / 16, nb = q % 16;
        t.W = ed + (size_t)e * DE * D; t.WT = EDp + (size_t)e * D * DE; t.gain = nullptr; t.K = DE; t.N = D; t.k0 = kb * 64; t.n0 = nb * 64; t.drow0 = ((nb * 64) & ~255) + 32 * (nb & 3); t.perm = 1; }
    return t;
}
DI void convert_experts(Frame& F, const float* eg, const float* eu, const float* ed, const float* gain, bf16* EGUp, bf16* EDp, int kbeg = 0, int kend = 1024) {
    const int gw_ = F.vcu * NWAVES + F.wave, NGW_ = F.G * NWAVES; const int NIT = min(32 * 3 * 128, kend * NGW_);
    f32x4 va[16], vb[16];
    int it = gw_ + kbeg * NGW_;
    if (it < NIT) { TItem ta = expert_item(it, eg, eu, ed, gain, EGUp, EDp); titem_load(ta, va, F.lane); }
    for (; it < NIT; it += 2 * NGW_) {
        const int it2 = it + NGW_, it3 = it + 2 * NGW_;
        if (it2 < NIT) { TItem tb = expert_item(it2, eg, eu, ed, gain, EGUp, EDp); titem_load(tb, vb, F.lane); }
        { TItem ta = expert_item(it, eg, eu, ed, gain, EGUp, EDp); titem_store(ta, va, F.lane); }
        if (it3 < NIT) { TItem ta = expert_item(it3, eg, eu, ed, gain, EGUp, EDp); titem_load(ta, va, F.lane); }
        if (it2 < NIT) { TItem tb = expert_item(it2, eg, eu, ed, gain, EGUp, EDp); titem_store(tb, vb, F.lane); }
    }
}
DI void expjob_item(const ExpJob& J, int k, int lane) {
    const int it = J.gw + k * J.ngw; if (it >= 32 * 3 * 128) return;
    const TItem t = expert_item(it, J.eg, J.eu, J.ed, J.gain, J.EGUp, J.EDp); f32x4 v[16]; titem_load(t, v, lane); titem_store(t, v, lane);
}
struct P0Src { const float *eg, *eu, *ed, *egain, *w_in, *g_in, *w_out, *w_q, *g_q, *w_kv, *g_kv, *w_o; bf16 *EGUp, *EDp, *WINp, *WOUTp, *WQKVp, *WOp; };
DI TItem dense_item(int it, const P0Src& P) {
    TItem t; t.K = D; int nnb, drow_off = 0, mode = 0;
    if (it < 768) { t.W = P.w_in; t.WT = P.WINp; t.gain = P.g_in; t.N = 3 * D; nnb = 48; mode = 1; }
    else if (it < 1024) { it -= 768; t.W = P.w_out; t.WT = P.WOUTp; t.gain = nullptr; t.N = D; nnb = 16; }
    else if (it < 1280) { it -= 1024; t.W = P.w_q; t.WT = P.WQKVp; t.gain = P.g_q; t.N = D; nnb = 16; }
    else if (it < 1792) { it -= 1280; t.W = P.w_kv; t.WT = P.WQKVp; t.gain = P.g_kv; t.N = 2 * D; nnb = 32; drow_off = D; }
    else { it -= 1792; t.W = P.w_o; t.WT = P.WOp; t.gain = nullptr; t.N = D; nnb = 16; }
    const int kb = it / nnb, nb = it % nnb, n0 = nb * 64; int drow0 = n0 + drow_off;
    if (mode == 1 && n0 >= 1024) { const int ch = (n0 - 1024) & 1023, isu = (n0 >= 2048) ? 1 : 0; drow0 = 1024 + (ch >> 7) * 256 + isu * 128 + (ch & 127); }
    t.k0 = kb * 64; t.n0 = n0; t.drow0 = drow0; t.perm = 0;
    if (t.W == P.w_out || t.W == P.w_o || t.W == P.w_q || (mode == 1 && n0 < 1024)) { t.perm = 1; t.drow0 = (n0 & ~255) + 32 * ((n0 >> 6) & 3); }
    return t;
}
DI void p0_convert_all(Frame& F, const P0Src& P) {
    const int gw_ = F.vcu * NWAVES + F.wave, NGW_ = F.G * NWAVES;
    const int KE = P.eg ? (32 * 3 * 128 - gw_ + NGW_ - 1) / NGW_ : 0, KD = (2048 - gw_ + NGW_ - 1) / NGW_, KT = (KE > 0 ? KE : 0) + (KD > 0 ? KD : 0);
#define P0_ITEM(k) (((k) < KE) ? expert_item(gw_ + (k) * NGW_, P.eg, P.eu, P.ed, P.egain, P.EGUp, P.EDp) : dense_item(gw_ + ((k) - KE) * NGW_, P))
    f32x4 va[16], vb[16];
    if (KT > 0) { const TItem t = P0_ITEM(0); titem_load(t, va, F.lane); }
    for (int k = 0; k < KT; k += 2) {
        if (k + 1 < KT) { const TItem t = P0_ITEM(k + 1); titem_load(t, vb, F.lane); }
        { const TItem t = P0_ITEM(k); titem_store(t, va, F.lane); }
        if (k + 2 < KT) { const TItem t = P0_ITEM(k + 2); titem_load(t, va, F.lane); }
        if (k + 1 < KT) { const TItem t = P0_ITEM(k + 1); titem_store(t, vb, F.lane); }
    }
#undef P0_ITEM
}
DI const float* hrow(const float* mainp, const float* metap, int r) { return r < TR ? mainp + (size_t)r * D : metap + (size_t)(r - TR) * D; }
struct Row16 { f32x4 v[4]; };
DI Row16 load_row(const float* p, int lane) { Row16 x; const f32x4* q = (const f32x4*)p + lane;
#pragma unroll
    for (int j = 0; j < 4; ++j) x.v[j] = __builtin_nontemporal_load(&q[64 * j]);
    return x; }
DI float row_sumsq(const Row16& x) { float s = 0.f;
#pragma unroll
    for (int j = 0; j < 4; ++j) s += (x.v[j][0] * x.v[j][0] + x.v[j][1] * x.v[j][1]) + (x.v[j][2] * x.v[j][2] + x.v[j][3] * x.v[j][3]);
    return wave_sum(s); }
DI void store_row_bf16(bf16* p, const Row16& x, float sc, int lane) { u32x2* q = (u32x2*)p + lane;
#pragma unroll
    for (int j = 0; j < 4; ++j) { u32x2 w; w.x = cvtpk(x.v[j][0] * sc, x.v[j][1] * sc); w.y = cvtpk(x.v[j][2] * sc, x.v[j][3] * sc); q[64 * j] = w; } }
struct Row8 { u32x2 w[4]; };
DI Row8 load_row8(const bf16* p, int lane) { Row8 y; const u32x2* q = (const u32x2*)p + lane;
#pragma unroll
    for (int j = 0; j < 4; ++j) y.w[j] = q[64 * j];
    return y; }
DI Row8 load_row8_nt(const bf16* p, int lane) { Row8 y; const u32x2* q = (const u32x2*)p + lane;
#pragma unroll
    for (int j = 0; j < 4; ++j) y.w[j] = __builtin_nontemporal_load(&q[64 * j]);
    return y; }
DI void add_row8(Row16& x, const Row8& y) {
#pragma unroll
    for (int j = 0; j < 4; ++j) { x.v[j][0] += bflo(y.w[j].x); x.v[j][1] += bfhi(y.w[j].x); x.v[j][2] += bflo(y.w[j].y); x.v[j][3] += bfhi(y.w[j].y); } }
DI void add_row_bf16(Row16& x, const bf16* p, int lane) { const u32x2* q = (const u32x2*)p + lane;
#pragma unroll
    for (int j = 0; j < 4; ++j) { const u32x2 w = q[64 * j]; x.v[j][0] += bflo(w.x); x.v[j][1] += bfhi(w.x); x.v[j][2] += bflo(w.y); x.v[j][3] += bfhi(w.y); } }
struct RowB { u32x4 w[2]; };
DI RowB load_rowb(const bf16* p, int lane) { RowB y; const u32x4* q = (const u32x4*)p + lane; y.w[0] = q[0]; y.w[1] = q[64]; return y; }
DI RowB load_rowb_nt(const bf16* p, int lane) { RowB y; const u32x4* q = (const u32x4*)p + lane; y.w[0] = __builtin_nontemporal_load(&q[0]); y.w[1] = __builtin_nontemporal_load(&q[64]); return y; }
struct RowF { float v[16]; };
DI void rowf_set(RowF& x, const RowB& y) {
#pragma unroll
    for (int j = 0; j < 2; ++j)
#pragma unroll
        for (int q = 0; q < 4; ++q) { x.v[8 * j + 2 * q] = bflo(y.w[j][q]); x.v[8 * j + 2 * q + 1] = bfhi(y.w[j][q]); } }
DI void rowf_add(RowF& x, const RowB& y) {
#pragma unroll
    for (int j = 0; j < 2; ++j)
#pragma unroll
        for (int q = 0; q < 4; ++q) { x.v[8 * j + 2 * q] += bflo(y.w[j][q]); x.v[8 * j + 2 * q + 1] += bfhi(y.w[j][q]); } }
DI float rowf_sumsq(const RowF& x) { float s = 0.f;
#pragma unroll
    for (int i = 0; i < 16; i += 2) s += x.v[i] * x.v[i] + x.v[i + 1] * x.v[i + 1];
    return wave_sum(s); }
DI void store_rowb(bf16* p, const RowF& x, int lane) { u32x4* q = (u32x4*)p + lane;
#pragma unroll
    for (int j = 0; j < 2; ++j) { u32x4 w;
#pragma unroll
        for (int k = 0; k < 4; ++k) w[k] = cvtpk(x.v[8 * j + 2 * k], x.v[8 * j + 2 * k + 1]);
        q[64 * j] = w; } }
DI void route_phase(Frame& F, const bf16* HBp, int nrows, const bf16* RWBp, const float* bg, const float* be, unsigned* cnt, unsigned* list, float* rstd_out, float* rstdp, unsigned* gatep) {
    const int lane = F.lane, row = lane & 15, kq = lane >> 4;
    const int ngroups = (nrows + 15) >> 4;
    LAS float* L = (LAS float*)(F.lds + F.wave * 4096);
    volatile LAS unsigned* hist = F.MISC + 128; volatile LAS unsigned* base = F.MISC + 160;
    constexpr int WOFF = 32768, WPITCH = 2064;
    for (int c = F.tid; c < 48 * 128; c += NWAVES * 64) { const int wr_ = c >> 7, wc_ = c & 127;
        *(LAS u32x4*)(F.lds + WOFF + wr_ * WPITCH + wc_ * 16) = *(const u32x4*)(RWBp + (size_t)wr_ * D + wc_ * 8); }
    __syncthreads();
    for (int g0 = F.vcu * NWAVES; g0 < ngroups; g0 += F.G * NWAVES) {
        const int g = g0 + F.wave; const bool act = g < ngroups;
        int e0 = 0, e1 = 0; float gt0 = 0.f, gt1 = 0.f, rstd_t = 0.f; unsigned rk0 = 0, rk1 = 0; int tok = 0; bool tv = false;
        if (act) {
            const int r = g * 16 + row; const int rc = r < nrows ? r : nrows - 1;
            const bf16* xp = HBp + (size_t)rc * D + 16 * kq;
            f32x4 acc[3] = {{0.f, 0.f, 0.f, 0.f}, {0.f, 0.f, 0.f, 0.f}, {0.f, 0.f, 0.f, 0.f}};
            float ssq = 0.f;
            u32x4 xw[16][2];
#pragma unroll
            for (int sp = 0; sp < 16; ++sp) { xw[sp][0] = *(const u32x4*)(xp + 64 * sp); xw[sp][1] = *(const u32x4*)(xp + 64 * sp + 8); }
            const LAS unsigned char* wl = F.lds + WOFF + row * WPITCH + 32 * kq;
#pragma unroll
            for (int sp = 0; sp < 16; ++sp) {
                bf16x8 bw[3][2];
#pragma unroll
                for (int nb = 0; nb < 3; ++nb)
#pragma unroll
                    for (int hf = 0; hf < 2; ++hf) bw[nb][hf] = *(const LAS bf16x8*)(wl + nb * 16 * WPITCH + 128 * sp + 16 * hf);
#pragma unroll
                for (int hf = 0; hf < 2; ++hf) {
#pragma unroll
                    for (int q = 0; q < 4; ++q) { const float lo = bflo(xw[sp][hf][q]), hi = bfhi(xw[sp][hf][q]); ssq += lo * lo + hi * hi; }
                    const bf16x8 ah = __builtin_bit_cast(bf16x8, xw[sp][hf]);
#pragma unroll
                    for (int nb = 0; nb < 3; ++nb) acc[nb] = __builtin_amdgcn_mfma_f32_16x16x32_bf16(ah, bw[nb][hf], acc[nb], 0, 0, 0);
                }
            }
            ssq += __shfl_xor(ssq, 16); ssq += __shfl_xor(ssq, 32);
            const float rstd = 1.0f / sqrtf(ssq * (1.0f / D) + EPS);
            if (kq == 0 && r < nrows) rstd_out[r] = rstd;
            rstd_t = rstd;
#pragma unroll
            for (int nb = 0; nb < 3; ++nb)
#pragma unroll
                for (int i = 0; i < 4; ++i) L[(4 * kq + i) * 52 + 16 * nb + row] = acc[nb][i];
            LDS_WAIT();
            tok = g * 16 + lane; tv = (lane < 16) && (tok < nrows);
            if (tv) {
                const LAS float* lt = L + lane * 52;
                float gl[4]; float gmax = -INFINITY; int grp = 0;
#pragma unroll
                for (int q = 0; q < 4; ++q) { gl[q] = lt[q] * rstd + bg[q]; if (gl[q] > gmax) { gmax = gl[q]; grp = q; } }
                float gs = 0.f;
#pragma unroll
                for (int q = 0; q < 4; ++q) gs += expf(gl[q] - gmax);
                const float pgrp = 1.0f / gs;
                float v0 = -INFINITY, v1 = -INFINITY; int i0 = 0, i1 = 0;
#pragma unroll
                for (int j = 0; j < 8; ++j) { const float v = lt[4 + 8 * grp + j] * rstd + be[8 * grp + j];
                    if (v > v0) { v1 = v0; i1 = i0; v0 = v; i0 = j; } else if (v > v1) { v1 = v; i1 = j; } }
                const float ex = expf(v1 - v0); gt0 = pgrp / (1.0f + ex); gt1 = pgrp * ex / (1.0f + ex);
                e0 = grp * 8 + i0; e1 = grp * 8 + i1;
                rk0 = __hip_atomic_fetch_add((LAS unsigned*)(hist + e0), 1u, __ATOMIC_RELAXED, __HIP_MEMORY_SCOPE_WORKGROUP);
                rk1 = __hip_atomic_fetch_add((LAS unsigned*)(hist + e1), 1u, __ATOMIC_RELAXED, __HIP_MEMORY_SCOPE_WORKGROUP);
            }
        }
        __syncthreads();
        if (F.tid < 32) { const unsigned c = hist[F.tid]; if (c) base[F.tid] = atomicAdd(cnt + F.tid, c); }
        __syncthreads();
        if (tv) {
            const unsigned p0 = base[e0] + rk0, p1 = base[e1] + rk1;
            list[(size_t)e0 * CAP + p0] = (unsigned)tok * 2u;      gatep[(size_t)e0 * CAP + p0] = ((unsigned)tok * 2u)      | ((unsigned)(gt0 * 32767.0f + 0.5f) << 17); rstdp[(size_t)e0 * CAP + p0] = rstd_t;
            list[(size_t)e1 * CAP + p1] = (unsigned)tok * 2u + 1u; gatep[(size_t)e1 * CAP + p1] = ((unsigned)tok * 2u + 1u) | ((unsigned)(gt1 * 32767.0f + 0.5f) << 17); rstdp[(size_t)e1 * CAP + p1] = rstd_t;
        }
        __syncthreads();
        if (F.tid < 32) hist[F.tid] = 0u;
        __syncthreads();
    }
}
DI void moe_tables(Frame& F, const unsigned* cnt) {
    volatile LAS int* pre = (volatile LAS int*)(F.MISC + 16); volatile LAS int* lc = (volatile LAS int*)(F.MISC + 64);
    __syncthreads();
    if (F.tid == 0) { int acc = 0; for (int e = 0; e < 32; ++e) { const int n = (int)__hip_atomic_load(cnt + e, __ATOMIC_RELAXED, __HIP_MEMORY_SCOPE_AGENT); lc[e] = n; pre[e] = acc; acc += (n + 255) >> 8; } pre[32] = acc; }
    __syncthreads();
}

struct Args { const float* in[22]; float* out; unsigned char* ws; int ph_lo, ph_hi, use_bar, pad; };
constexpr int NPHASE = 15;


typedef const Args __attribute__((address_space(4)))* KArgsP;
DI KArgsP kargs_ptr() { auto p = __builtin_amdgcn_kernarg_segment_ptr(); asm volatile("" : "+s"(p)); return (KArgsP)p; }
#define KARGS() KArgsP AP = kargs_ptr()
__global__ void __launch_bounds__(NWAVES * 64, 2) mk_fwd(Args args) {
    extern __shared__ __attribute__((aligned(16))) unsigned char lds_raw[];
    Frame F;
    F.lds = (LAS unsigned char*)lds_raw; F.MISC = (volatile LAS unsigned*)(F.lds + MISC_OFF);
    F.tid = threadIdx.x; F.lane = F.tid & 63; F.wave = __builtin_amdgcn_readfirstlane(F.tid >> 6);
    F.G = gridDim.x; { const int bx = blockIdx.x; F.vcu = (F.G % 8 == 0) ? (bx % 8) * (F.G / 8) + bx / 8 : bx; }
    F.ws = args.ws; F.ctl = (unsigned*)(args.ws + WS_CTL);
    for (int u = F.tid; u < (LDS_BYTES - MISC_OFF) / 4; u += NWAVES * 64) F.MISC[u] = 0u;
    __syncthreads();
    XcdBarrier bar; bar.bar = F.ctl + CW_BAR; bar.x = 0; bar.st = nullptr;
    if (args.use_bar) bar = xcd_barrier_post(F.ctl + CW_BAR, F.MISC);
#define GRID_BAR() do { xcd_barrier(bar); } while (0)
    const int lo = args.ph_lo, hi = args.ph_hi;
#ifdef PH_ONLY
#define IN(k) ((k) == PH_ONLY)
#else
#define IN(k) (lo <= (k) && (k) < hi)
#endif
#define SEAM(k) do { if (IN(k) && IN((k) + 1)) GRID_BAR(); F_REFRESH(); } while (0)
#define F_REFRESH() do { int t_ = threadIdx.x; asm volatile("" : "+v"(t_)); F.tid = t_; F.lane = t_ & 63; } while (0)

#define x_in (AP->in[0])
#define meta_tokens (AP->in[1])
#define a_norm (AP->in[2])
#define a_w_in (AP->in[3])
#define a_conv (AP->in[4])
#define a_w_out (AP->in[5])
#define kv_norm (AP->in[6])
#define w_kv (AP->in[7])
#define b_norm (AP->in[8])
#define b_w_q (AP->in[9])
#define b_lambda (AP->in[10])
#define b_subln (AP->in[11])
#define b_w_out (AP->in[12])
#define ffn_norm (AP->in[13])
#define r_group (AP->in[14])
#define r_group_b (AP->in[15])
#define r_expert (AP->in[16])
#define r_expert_b (AP->in[17])
#define e_gate (AP->in[18])
#define e_up (AP->in[19])
#define e_down (AP->in[20])
#define final_norm (AP->in[21])
#define out (AP->out)
#define ws (AP->ws)
#define RWB ((bf16*)(ws + WS_RW))
#define ROPE ((float*)(ws + WS_ROPE))
#define RSTDP ((float*)(ws + WS_RSTDP))
#define GATEP ((unsigned*)(ws + WS_GATEP))
#define LIST ((unsigned*)(ws + WS_LIST))
#define WIN ((bf16*)(ws + WS_WIN))
#define WOUT ((bf16*)(ws + WS_WOUT))
#define WQKV ((bf16*)(ws + WS_WQKV))
#define WO ((bf16*)(ws + WS_WO))
#define EGU ((bf16*)(ws + WS_EGU))
#define ED ((bf16*)(ws + WS_ED))
#define XN ((bf16*)(ws + WS_XN))
#define HB XN
#define RSTD ((float*)(ws + WS_RSTD))
#define R2 ((bf16*)(ws + WS_R2))
#define R3 ((bf16*)(ws + WS_R3))
#define ACT R2
#define Y ((bf16*)(ws + WS_Y))
#define KB ((bf16*)(ws + WS_K))
#define VB ((bf16*)(ws + WS_V))
#define V8B ((unsigned char*)(ws + WS_V8))
#define K8B ((unsigned char*)(ws + WS_K8))
#define Q8B ((unsigned char*)(ws + WS_R2))
#define CNT0 (F.ctl + CW_CNT)
#define CNT1 (F.ctl + CW_CNT + 32)
#define gw (F.vcu * NWAVES + F.wave)
#define NGW (F.G * NWAVES)
#define gt (gw * 64 + F.lane)
#define NGT (NGW * 64)
#define scr ((LAS float*)(F.lds + F.wave * 16384))

    if (IN(0)) { KARGS();
        { const P0Src P{nullptr, e_up, e_down, ffn_norm, a_w_in, a_norm, a_w_out, b_w_q, b_norm, w_kv, kv_norm, b_w_out, EGU, ED, WIN, WOUT, WQKV, WO}; p0_convert_all(F, P); }
        for (int i = gt; i < 2 * 48 * D; i += NGT) { const int l = i / (48 * D), o = (i / D) % 48, k = i % D;
            float w = 0.f;
            if (o < 36) w = ((o < 4) ? r_group[((size_t)l * D + k) * NGRP + o] : r_expert[((size_t)l * D + k) * NE + (o - 4)]) * ffn_norm[l * D + k];
            RWB[i] = (bf16)(cvtpk(w, 0.f) & 0xffffu); }
        for (int i = gt; i < (SEQ + NMETA + 3) * 8; i += NGT) { const int row = i >> 3, j = i & 7;
            const int pos = row < SEQ + NMETA ? row : (row == SEQ + NMETA ? 16 : (row == SEQ + NMETA + 1 ? 80 : 128));
            const float inv = (float)pow(500000.0, -(double)j / 8.0); const float ang = (float)pos * inv;
            ROPE[row * 16 + j] = (float)cos((double)ang); ROPE[row * 16 + 8 + j] = (float)sin((double)ang); }
        for (int r = gw; r < NV; r += 2 * NGW) { const int r2 = r + NGW; const bool h2 = r2 < NV;
            const Row16 xa = load_row(hrow(x_in, meta_tokens, r), F.lane); Row16 xb = xa; if (h2) xb = load_row(hrow(x_in, meta_tokens, r2), F.lane);
            const float ra = 1.0f / sqrtf(row_sumsq(xa) * (1.0f / D) + EPS), rb = 1.0f / sqrtf(row_sumsq(xb) * (1.0f / D) + EPS);
            store_row_bf16(HB + (size_t)r * D, xa, 1.0f, F.lane); if (h2) store_row_bf16(HB + (size_t)r2 * D, xb, 1.0f, F.lane);
            if (F.lane == 0) { RSTD[r] = ra; if (h2) RSTD[r2] = rb; } }
    }
    SEAM(0);
    if (IN(1)) { KARGS();
        if (gw < 64) {
            const int j = gw, ch0 = 16 * j, crow = 1024 + (ch0 >> 7) * 256 + (ch0 & 127); const bf16* A16 = HB + (size_t)TR * D;
            f32x4 ab, ac, au; meta_tile3(A16, D, WIN + (size_t)perm_row(ch0) * D, WIN + (size_t)crow * D, WIN + (size_t)(crow + 128) * D, D, F.lane, ab, ac, au);
#pragma unroll
            for (int i = 0; i < 4; ++i) { const int r = TR + 4 * (F.lane >> 4) + i; const float rs = RSTD[r];
                R2[(size_t)r * D + ch0 + (F.lane & 15)] = f2bf(ab[i] * rs); R3[(size_t)r * D + ch0 + (F.lane & 15)] = f2bf(ac[i] * au[i] * rs * rs); }
        }
        DenseSched S{HB, WIN, D, 12, F.G, (int)blockIdx.x, 0, 0, ExpJob{e_gate, e_up, e_down, ffn_norm, EGU, ED, gw, NGW}}; EpiInProj E{R2, R3, RSTD, {}};
        pg8::gemm_phase<EpiInProj, DenseSched, true>(F.lds, D, S, E);
        { const int nun = (1536 - (int)blockIdx.x + F.G - 1) / F.G, kmax = (32 * 3 * 128 + NGW - 1) / NGW;
          for (int k = nun; k < kmax; ++k) expjob_item(S.job, k, F.lane); }
    }
    SEAM(1);
    if (IN(2)) { KARGS();
        f32x4 cw[3][4];
#pragma unroll
        for (int k = 0; k < 3; ++k)
#pragma unroll
            for (int j = 0; j < 4; ++j) cw[k][j] = *((const f32x4*)(a_conv + k * D) + F.lane + 64 * j);
        if (gw < 16) {
            const int r = TR + gw; const float z1 = gw >= 1 ? 1.f : 0.f, z2 = gw >= 2 ? 1.f : 0.f;
            const Row8 c0 = load_row8(R3 + (size_t)r * D, F.lane), bb = load_row8(R2 + (size_t)r * D, F.lane);
            const Row8 c1 = load_row8(R3 + (size_t)(gw >= 1 ? r - 1 : r) * D, F.lane), c2 = load_row8(R3 + (size_t)(gw >= 2 ? r - 2 : r) * D, F.lane);
            u32x2 ov[4];
#pragma unroll
            for (int j = 0; j < 4; ++j) { const u32x2 wb = bb.w[j], w0 = c0.w[j], w1 = c1.w[j], w2 = c2.w[j];
                const float m0 = bflo(wb.x) * (cw[2][j][0] * bflo(w0.x) + z1 * cw[1][j][0] * bflo(w1.x) + z2 * cw[0][j][0] * bflo(w2.x));
                const float m1 = bfhi(wb.x) * (cw[2][j][1] * bfhi(w0.x) + z1 * cw[1][j][1] * bfhi(w1.x) + z2 * cw[0][j][1] * bfhi(w2.x));
                const float m2 = bflo(wb.y) * (cw[2][j][2] * bflo(w0.y) + z1 * cw[1][j][2] * bflo(w1.y) + z2 * cw[0][j][2] * bflo(w2.y));
                const float m3 = bfhi(wb.y) * (cw[2][j][3] * bfhi(w0.y) + z1 * cw[1][j][3] * bfhi(w1.y) + z2 * cw[0][j][3] * bfhi(w2.y));
                ov[j].x = cvtpk(m0, m1); ov[j].y = cvtpk(m2, m3); }
            u32x2* po = (u32x2*)(R2 + (size_t)r * D) + F.lane;
#pragma unroll
            for (int j = 0; j < 4; ++j) po[64 * j] = ov[j];
        }
        for (int g = gw; g < TR / 16; g += NGW) {
            const int r0 = 16 * g;
            int q1, q2; float z = 1.f;
            if (r0 >= TR) { q1 = r0; q2 = r0; z = 0.f; } else if ((r0 & (SEQ - 1)) == 0) { q1 = TR + 15; q2 = TR + 14; } else { q1 = r0 - 1; q2 = r0 - 2; }
            Row8 c1 = load_row8(R3 + (size_t)q1 * D, F.lane), c2 = load_row8(R3 + (size_t)q2 * D, F.lane);
            float z1 = z, z2 = z;
#pragma unroll 4
            for (int i = 0; i < 16; ++i) {
                const int r = r0 + i;
                const Row8 c0 = load_row8_nt(R3 + (size_t)r * D, F.lane), bb = load_row8_nt(R2 + (size_t)r * D, F.lane);
                u32x2 ov[4];
#pragma unroll
                for (int j = 0; j < 4; ++j) { const u32x2 wb = bb.w[j], w0 = c0.w[j], w1 = c1.w[j], w2 = c2.w[j];
                    const float m0 = bflo(wb.x) * (cw[2][j][0] * bflo(w0.x) + z1 * cw[1][j][0] * bflo(w1.x) + z2 * cw[0][j][0] * bflo(w2.x));
                    const float m1 = bfhi(wb.x) * (cw[2][j][1] * bfhi(w0.x) + z1 * cw[1][j][1] * bfhi(w1.x) + z2 * cw[0][j][1] * bfhi(w2.x));
                    const float m2 = bflo(wb.y) * (cw[2][j][2] * bflo(w0.y) + z1 * cw[1][j][2] * bflo(w1.y) + z2 * cw[0][j][2] * bflo(w2.y));
                    const float m3 = bfhi(wb.y) * (cw[2][j][3] * bfhi(w0.y) + z1 * cw[1][j][3] * bfhi(w1.y) + z2 * cw[0][j][3] * bfhi(w2.y));
                    ov[j].x = cvtpk(m0, m1); ov[j].y = cvtpk(m2, m3); }
                u32x2* po = (u32x2*)(R2 + (size_t)r * D) + F.lane;
#pragma unroll
                for (int j = 0; j < 4; ++j) po[64 * j] = ov[j];
                c2 = c1; c1 = c0; z2 = z1; z1 = 1.f;
            }
        }
    }
    SEAM(2);
    if (IN(3)) { KARGS();
        if (gw < 64) {
            const int c0 = 16 * gw; const f32x4 a = meta_tile(R2 + (size_t)TR * D, D, WOUT + (size_t)perm_row(c0) * D, D, F.lane);
#pragma unroll
            for (int i = 0; i < 4; ++i) { const int rr = 4 * (F.lane >> 4) + i, c = c0 + (F.lane & 15); HB[(size_t)(TR + rr) * D + c] = f2bf(meta_tokens[rr * D + c] + a[i]); }
        }
        DenseSched S{R2, WOUT, D, 4, F.G, (int)blockIdx.x, 0, 0}; EpiResid<false> E{nullptr, nullptr, HB};
        pg8::gemm_phase<EpiResid<false>, DenseSched, true>(F.lds, D, S, E);
    }
    SEAM(3);
    if (IN(4)) { KARGS();
        route_phase(F, HB, NV, RWB, r_group_b, r_expert_b, CNT0, LIST, RSTD, RSTDP, GATEP);
    }
    SEAM(4);
    if (IN(5)) { KARGS();
        moe_tables(F, CNT0);
        MoeSched<true> S{HB, EGU, D, F.G, F.vcu, (volatile LAS int*)(F.MISC + 16), (volatile LAS int*)(F.MISC + 64), LIST, F.ctl + CW_SIG, F.MISC, bar.x}; EpiMoeUp E{ACT, LIST, RSTDP, (volatile LAS int*)(F.MISC + 64), {}};
        pg8::gemm_phase<EpiMoeUp, MoeSched<true>, true>(F.lds, D, S, E);
    }
    if (IN(5) && IN(6)) { moe_handoff(F.ctl + CW_SIG, (volatile LAS int*)(F.MISC + 16), F.G, F.vcu, F.ctl + CW_BAR); F_REFRESH(); } else SEAM(5);
    if (IN(6)) { KARGS();
        moe_tables(F, CNT0);
        MoeSched<false> S{ACT, ED, DE, F.G, F.vcu, (volatile LAS int*)(F.MISC + 16), (volatile LAS int*)(F.MISC + 64), LIST, nullptr, nullptr, 0u};
        EpiMoeDown E{Y, LIST, GATEP, (volatile LAS int*)(F.MISC + 64), {}};
        pg8::gemm_phase<EpiMoeDown, MoeSched<false>, true>(F.lds, DE, S, E);
    }
    SEAM(6);
    if (IN(7)) { KARGS();
        for (int r = gw; r < NV; r += 2 * NGW) { const int r2 = r + NGW; const bool h2 = r2 < NV; const int rr2 = h2 ? r2 : r;
            const RowB ha = load_rowb(HB + (size_t)r * D, F.lane), hb2 = load_rowb(HB + (size_t)rr2 * D, F.lane);
            const RowB ya0 = load_rowb_nt(Y + (size_t)r * D, F.lane), ya1 = load_rowb_nt(Y + ((size_t)MP + r) * D, F.lane);
            const RowB yb0 = load_rowb_nt(Y + (size_t)rr2 * D, F.lane), yb1 = load_rowb_nt(Y + ((size_t)MP + rr2) * D, F.lane);
            RowF xa, xb; rowf_set(xa, ha); rowf_add(xa, ya0); rowf_add(xa, ya1); rowf_set(xb, hb2); rowf_add(xb, yb0); rowf_add(xb, yb1);
            const float ra = 1.0f / sqrtf(rowf_sumsq(xa) * (1.0f / D) + EPS), rb = 1.0f / sqrtf(rowf_sumsq(xb) * (1.0f / D) + EPS);
            store_rowb(HB + (size_t)r * D, xa, F.lane); if (h2) store_rowb(HB + (size_t)r2 * D, xb, F.lane);
            if (F.lane == 0) { RSTD[r] = ra; if (h2) RSTD[r2] = rb; } }
    }
    SEAM(7);
    if (IN(8)) { KARGS();
        if (gw < 128) {
            const int sec = gw >> 6, c0 = 16 * (gw & 63), n = F.lane & 15, g4 = F.lane >> 4;
            const f32x4 a = meta_tile(HB + (size_t)TR * D, D, WQKV + (size_t)(1024 + 1024 * sec + c0) * D, D, F.lane); f32x4 mv = {0.f, 0.f, 0.f, 0.f};
#pragma unroll
            for (int i = 0; i < 4; ++i) { const int rr = 4 * g4 + i; float v = a[i] * RSTD[TR + rr]; const float p = __shfl_xor(v, 8);
                if (sec == 0 && (c0 & 63) == 0) { const float cs = ROPE[rr * 16 + (n & 7)], sn = ROPE[rr * 16 + 8 + (n & 7)]; v = (n < 8) ? v * cs - p * sn : v * cs + p * sn; }
                mv[i] = v; }
            unsigned char* himg = (sec == 0 ? K8B : V8B) + ((size_t)((TR / 64) * 8 + (c0 >> 7))) * 8192; const unsigned w = pk4_fp8(mv);
            if (sec == 0) {
                const int dh = c0 & 127; unsigned char* kp = himg + (dh >> 6) * 4096 + ((dh >> 4) & 1) * 1024 + ((dh >> 5) & 1) * 512 + n;
#pragma unroll
                for (int i = 0; i < 4; ++i) kp[(4 * g4 + i) * 16] = (unsigned char)(w >> (8 * i));
#pragma unroll
                for (int j = 0; j < 4; ++j) kp[(16 + g4 + 4 * j) * 16] = 0;
#pragma unroll
                for (int j = 0; j < 8; ++j) kp[2048 + (g4 + 4 * j) * 16] = 0;
            } else {
                unsigned char* img = himg + ((c0 & 127) >> 5) * 1024 + (g4 & 1) * 512 + ((c0 & 31) + n) * 16 + 8 * (F.lane >> 5);
                *(u32x2*)img = (u32x2){w, 0u}; *(u32x2*)(img + 4096) = (u32x2){0u, 0u};
            }
        }
        DenseSched S{HB, WQKV, D, 12, F.G, (int)blockIdx.x, 0, 0}; EpiQKV E{Q8B, K8B, V8B, ROPE, RSTD, {}};
        pg8::gemm_phase<EpiQKV, DenseSched, true>(F.lds, D, S, E);
    }
    SEAM(8);
    if (IN(9)) { KARGS();
        float d0 = 0.f, d1 = 0.f;
        for (int i = 0; i < HD; ++i) { d0 += b_lambda[i] * b_lambda[HD + i]; d1 += b_lambda[2 * HD + i] * b_lambda[3 * HD + i]; }
        const float lam = __uint_as_float(__builtin_amdgcn_readfirstlane(__float_as_uint(expf(d0) - expf(d1) + LAM_INIT)));
#pragma unroll 1
        for (int v = F.vcu; v < 256; v += F.G) {
            const int bh = v >> 3, s = v & 7;
#pragma unroll 1
            for (int i = 0; i < 4; ++i) { const int qb = (i == 0) ? s : (i == 1) ? 15 - s : (i == 2) ? 16 + s : 31 - s;
                att::attn_unit_checked(bh >> 3, bh & 7, qb, Q8B, K8B, V8B, R3, lam, b_subln, (LAS char*)F.lds, F.MISC + 200);
                if (v == F.vcu) convert_experts(F, e_gate + (size_t)NE * D * DE, e_up + (size_t)NE * D * DE, e_down + (size_t)NE * DE * D, ffn_norm + D, EGU, ED, 3 * (i >> 1), (i == 0) ? 3 : ((i == 2) ? 1024 : 0)); }
        }
    }
    SEAM(9);
    if (IN(10)) { KARGS();
        DenseSched S{R3, WO, D, 4, F.G, (int)blockIdx.x, 0, 0}; EpiResid<false> E{nullptr, nullptr, HB};
        pg8::gemm_phase<EpiResid<false>, DenseSched, true>(F.lds, D, S, E);
    }
    SEAM(10);
    if (IN(11)) { KARGS();
        route_phase(F, HB, TR, RWB + 48 * D, r_group_b + NGRP, r_expert_b + NE, CNT1, LIST, RSTD, RSTDP, GATEP);
    }
    SEAM(11);
    if (IN(12)) { KARGS();
        moe_tables(F, CNT1);
        MoeSched<true> S{HB, EGU, D, F.G, F.vcu, (volatile LAS int*)(F.MISC + 16), (volatile LAS int*)(F.MISC + 64), LIST, F.ctl + CW_SIG + 2048, F.MISC, bar.x}; EpiMoeUp E{ACT, LIST, RSTDP, (volatile LAS int*)(F.MISC + 64), {}};
        pg8::gemm_phase<EpiMoeUp, MoeSched<true>, true>(F.lds, D, S, E);
    }
    if (IN(12) && IN(13)) { moe_handoff(F.ctl + CW_SIG + 2048, (volatile LAS int*)(F.MISC + 16), F.G, F.vcu, F.ctl + CW_BAR); F_REFRESH(); } else SEAM(12);
    if (IN(13)) { KARGS();
        moe_tables(F, CNT1);
        MoeSched<false> S{ACT, ED, DE, F.G, F.vcu, (volatile LAS int*)(F.MISC + 16), (volatile LAS int*)(F.MISC + 64), LIST, nullptr, nullptr, 0u};
        EpiMoeDown E{Y, LIST, GATEP, (volatile LAS int*)(F.MISC + 64), {}};
        pg8::gemm_phase<EpiMoeDown, MoeSched<false>, true>(F.lds, DE, S, E);
    }
    SEAM(13);
    if (IN(14)) { KARGS();
        f32x4 fg[4];
#pragma unroll
        for (int j = 0; j < 4; ++j) fg[j] = *((const f32x4*)final_norm + F.lane + 64 * j);
        for (int r = gw; r < TR; r += 2 * NGW) { const int r2 = r + NGW;
            Row16 xa, xb;
#pragma unroll
            for (int j = 0; j < 4; ++j) { xa.v[j] = (f32x4){0.f, 0.f, 0.f, 0.f}; xb.v[j] = xa.v[j]; }
            const Row8 ha = load_row8_nt(HB + (size_t)r * D, F.lane), hb2 = load_row8_nt(HB + (size_t)r2 * D, F.lane);
            const Row8 ya0 = load_row8_nt(Y + (size_t)r * D, F.lane), ya1 = load_row8_nt(Y + ((size_t)MP + r) * D, F.lane);
            const Row8 yb0 = load_row8_nt(Y + (size_t)r2 * D, F.lane), yb1 = load_row8_nt(Y + ((size_t)MP + r2) * D, F.lane);
            add_row8(xa, ha); add_row8(xa, ya0); add_row8(xa, ya1); add_row8(xb, hb2); add_row8(xb, yb0); add_row8(xb, yb1);
            const float ra = 1.0f / sqrtf(row_sumsq(xa) * (1.0f / D) + EPS), rb = 1.0f / sqrtf(row_sumsq(xb) * (1.0f / D) + EPS);
            f32x4* qa = (f32x4*)(out + (size_t)r * D) + F.lane; f32x4* qb = (f32x4*)(out + (size_t)r2 * D) + F.lane;
#pragma unroll
            for (int j = 0; j < 4; ++j) { __builtin_nontemporal_store(xa.v[j] * ra * fg[j], &qa[64 * j]); __builtin_nontemporal_store(xb.v[j] * rb * fg[j], &qb[64 * j]); } }
    }
#undef IN
#undef SEAM
#undef GRID_BAR
#undef gw
#undef NGW
#undef gt
#undef NGT
#undef scr
#undef x_in
#undef meta_tokens
#undef a_norm
#undef a_w_in
#undef a_conv
#undef a_w_out
#undef kv_norm
#undef w_kv
#undef b_norm
#undef b_w_q
#undef b_lambda
#undef b_subln
#undef b_w_out
#undef ffn_norm
#undef r_group
#undef r_group_b
#undef r_expert
#undef r_expert_b
#undef e_gate
#undef e_up
#undef e_down
#undef final_norm
#undef out
#undef ws
#undef RWB
#undef ROPE
#undef RSTDP
#undef GATEP
#undef LIST
#undef WIN
#undef WOUT
#undef WQKV
#undef WO
#undef EGU
#undef ED
#undef XN
#undef HB
#undef RSTD
#undef R2
#undef R3
#undef ACT
#undef Y
#undef KB
#undef VB
#undef V8B
#undef K8B
#undef Q8B
#undef CNT0
#undef CNT1
}

#ifndef MK_SPLIT
#define MK_SPLIT 0
#endif
extern "C" void kernel_launch(void* const* d_in, const int* in_sizes, int n_in, void* d_out, int out_size, void* d_ws, size_t ws_size, hipStream_t stream) {
    static int grid = 0;
    if (grid == 0) {
        if (n_in != 22 || out_size != TR * D || ws_size < WS_END) { fprintf(stderr, "kernel_launch: unexpected sizes (n_in %d out %d ws %zu)\n", n_in, out_size, ws_size); grid = -1; return; }
        int dev = 0, cus = 0, per_cu = 0;
        if (hipGetDevice(&dev) != hipSuccess || hipDeviceGetAttribute(&cus, hipDeviceAttributeMultiprocessorCount, dev) != hipSuccess) { grid = -1; return; }
        if (hipFuncSetAttribute((const void*)mk_fwd, hipFuncAttributeMaxDynamicSharedMemorySize, LDS_BYTES) != hipSuccess) { fprintf(stderr, "kernel_launch: hipFuncSetAttribute failed\n"); grid = -1; return; }
        if (hipOccupancyMaxActiveBlocksPerMultiprocessor(&per_cu, (const void*)mk_fwd, NWAVES * 64, LDS_BYTES) != hipSuccess || per_cu < 1) { fprintf(stderr, "kernel_launch: occupancy query says %d\n", per_cu); }
        (void)hipGetLastError();
        grid = cus;
    }
    if (grid < 0) return;
    (void)hipMemsetAsync((char*)d_ws + WS_CTL, 0, CTL_ZERO_BYTES, stream);
    Args a{};
    for (int i = 0; i < 22; ++i) a.in[i] = (const float*)d_in[i];
    a.out = (float*)d_out; a.ws = (unsigned char*)d_ws; a.pad = 0;
#if MK_SPLIT
    for (int p = 0; p < NPHASE; ++p) { a.ph_lo = p; a.ph_hi = p + 1; a.use_bar = 0;
        hipLaunchKernelGGL(mk_fwd, dim3(grid), dim3(NWAVES * 64), LDS_BYTES, stream, a); }
#else
    a.ph_lo = 0; a.ph_hi = NPHASE; a.use_bar = 1;
    hipLaunchKernelGGL(mk_fwd, dim3(grid), dim3(NWAVES * 64), LDS_BYTES, stream, a);
#endif
}
```
